# Optimizing an MI355X kernel written in HIP

```python
import math
import jax, jax.numpy as jnp
from jax import lax
import numpy as np

D_MODEL = 1024
BATCH = 8
SEQ = 4096
DEPTH = 4
DEC_BATCH = 1
DEC_SEQ = 16384
PAST_LEN = 128

GRID_W = 64
HEAD_DIM = 64
N_HEADS_A = 8
NA_ROWS = 8
NA_COLS = 16
N_HEADS_B = 8
N_KV_B = 2
GROUP_B = N_HEADS_B // N_KV_B
ROPE_THETA = 10000.0
C_WIDTH = 512
CONV_K = 31
N_HEADS_D = 4
D_V_DIFF = 2 * HEAD_DIM
Q_BLOCK = 128
D_FF = -(-8 * D_MODEL // (3 * 256)) * 256
EPS = 1e-6
LN_EPS = 1e-5
N_AB = (DEPTH + 1) // 2
N_CD = DEPTH // 2
W_A = N_HEADS_A * HEAD_DIM
W_BQ = N_HEADS_B * HEAD_DIM
W_BKV = N_KV_B * HEAD_DIM
W_DQ = N_HEADS_D * 2 * HEAD_DIM
W_DV = N_HEADS_D * D_V_DIFF
AB_SPLITS = (W_A, W_A, W_A, W_BQ, W_BKV, W_BKV)
CD_SPLITS = (C_WIDTH, C_WIDTH, W_DQ, W_DQ, W_DV)
AB_IN = sum(AB_SPLITS)
CD_IN = sum(CD_SPLITS)
AB_OUT = W_A + W_BQ
CD_OUT = C_WIDTH + W_DV
ALIBI_SLOPES = tuple(2.0 ** (-8.0 * (h + 1) / N_HEADS_D) for h in range(N_HEADS_D))

kernel_name = 'hybrid_natten_gqa_conformer_diffattn_encoder'

F32 = jnp.float32


def _split(z, sizes):
    offs = np.cumsum(sizes)[:-1].tolist()
    return jnp.split(z, offs, axis=-1)


def _rms_norm(x, g):
    xf = x.astype(F32)
    y = xf * lax.rsqrt(jnp.mean(xf * xf, axis=-1, keepdims=True) + EPS)
    return (y * g.astype(F32)).astype(x.dtype)


def _layer_norm(x, g, b):
    xf = x.astype(F32)
    mu = jnp.mean(xf, axis=-1, keepdims=True)
    var = jnp.mean(jnp.square(xf - mu), axis=-1, keepdims=True)
    y = (xf - mu) * lax.rsqrt(var + LN_EPS)
    return (y * g.astype(F32) + b.astype(F32)).astype(x.dtype)


def _axial_rope(x):
    L = x.shape[1]
    t = jnp.arange(L, dtype=jnp.int32)
    row = (t // GRID_W).astype(F32)
    col = (t % GRID_W).astype(F32)
    half = HEAD_DIM // 2
    inv = ROPE_THETA ** (-jnp.arange(0, half, 2, dtype=F32) / half)
    ang = jnp.concatenate([row[:, None] * inv, col[:, None] * inv], axis=-1)
    cos = jnp.cos(ang)[None, :, None, :].astype(x.dtype)
    sin = jnp.sin(ang)[None, :, None, :].astype(x.dtype)
    x1 = x[..., 0::2]
    x2 = x[..., 1::2]
    out = jnp.stack([x1 * cos - x2 * sin, x1 * sin + x2 * cos], axis=-1)
    return out.reshape(x.shape)


def _neighborhood_attention(q, k, v, rpb):
    B, L, H, dh = q.shape
    rows = L // GRID_W
    kh = min(NA_ROWS, rows)
    n_nb = kh * NA_COLS
    scale = dh ** -0.5
    col = np.arange(GRID_W)
    cs = np.clip(col - NA_COLS // 2, 0, GRID_W - NA_COLS)
    kcol = cs[:, None] + np.arange(NA_COLS)[None, :]
    dcol = kcol - col[:, None]
    qb = q.reshape(B, rows, GRID_W, H, dh).swapaxes(0, 1)

    def row_block(args):
        qblk, r = args
        rs = jnp.clip(r - kh // 2, 0, rows - kh)
        krow = rs + jnp.arange(kh, dtype=jnp.int32)
        idx = (krow[None, :, None] * GRID_W + kcol[:, None, :]).reshape(GRID_W, n_nb)
        kn = k[:, idx]
        vn = v[:, idx]
        s = jnp.einsum('bqhd,bqnhd->bhqn', qblk, kn).astype(F32) * scale
        drow = krow - r
        bias = rpb[:, drow[None, :, None] + (NA_ROWS - 1), dcol[:, None, :] + (NA_COLS - 1)]
        s = s + bias.reshape(H, GRID_W, n_nb).astype(F32)[None]
        p = jax.nn.softmax(s, axis=-1).astype(v.dtype)
        return jnp.einsum('bhqn,bqnhd->bqhd', p, vn)

    o = lax.map(row_block, (qb, jnp.arange(rows, dtype=jnp.int32)))
    return o.swapaxes(0, 1).reshape(B, L, H * dh)


def _gqa_attention(q, k, v):
    B, L = q.shape[:2]
    nb = L // Q_BLOCK
    scale = HEAD_DIM ** -0.5
    qb = q.reshape(B, nb, Q_BLOCK, N_KV_B, GROUP_B, HEAD_DIM).swapaxes(0, 1)

    def block(qblk):
        s = jnp.einsum('bqkgd,bskd->bkgqs', qblk, k).astype(F32) * scale
        p = jax.nn.softmax(s, axis=-1).astype(v.dtype)
        return jnp.einsum('bkgqs,bskd->bqkgd', p, v)

    o = lax.map(block, qb)
    return o.swapaxes(0, 1).reshape(B, L, N_HEADS_B * HEAD_DIM)


def _diff_attention(q, k, v, lam):
    B, L = q.shape[:2]
    nb = L // Q_BLOCK
    scale = HEAD_DIM ** -0.5
    slopes = jnp.asarray(ALIBI_SLOPES, F32)
    kpos = jnp.arange(L, dtype=jnp.int32)
    qb = q.reshape(B, nb, Q_BLOCK, 2, N_HEADS_D, HEAD_DIM).swapaxes(0, 1)
    qpos = kpos.reshape(nb, Q_BLOCK)

    def block(args):
        qblk, qp = args
        s = jnp.einsum('bqmhd,bsmhd->bmhqs', qblk, k).astype(F32) * scale
        dist = jnp.abs(qp[:, None] - kpos[None, :]).astype(F32)
        s = s - slopes[:, None, None] * dist
        p = jax.nn.softmax(s, axis=-1)
        a = (p[:, 0] - lam * p[:, 1]).astype(v.dtype)
        return jnp.einsum('bhqs,bshe->bqhe', a, v)

    o = lax.map(block, (qb, qpos))
    return o.swapaxes(0, 1).reshape(B, L, N_HEADS_D, D_V_DIFF)


def _mixer_ab(h, p, j):
    B, L, _ = h.shape
    z = h @ p['w_in_ab'][j]
    qa, ka, va, qb, kb, vb = _split(z, AB_SPLITS)
    shp_a = (B, L, N_HEADS_A, HEAD_DIM)
    oa = _neighborhood_attention(qa.reshape(shp_a), ka.reshape(shp_a), va.reshape(shp_a), p['rpb_a'][j])
    qb = _axial_rope(_rms_norm(qb.reshape(B, L, N_HEADS_B, HEAD_DIM), p['qnorm_b'][j]))
    kb = _axial_rope(_rms_norm(kb.reshape(B, L, N_KV_B, HEAD_DIM), p['knorm_b'][j]))
    vb = vb.reshape(B, L, N_KV_B, HEAD_DIM)
    ob = _gqa_attention(qb, kb, vb)
    return jnp.concatenate([oa, ob], axis=-1) @ p['w_out_ab'][j]


def _mixer_cd(h, p, j, layer_idx):
    B, L, _ = h.shape
    z = h @ p['w_in_cd'][j]
    ca, cg, q, k, v = _split(z, CD_SPLITS)
    u = ca * jax.nn.sigmoid(cg)
    u = lax.conv_general_dilated(u, p['conv_w_c'][j][:, None, :], window_strides=(1,),
                                 padding=[(CONV_K // 2, CONV_K // 2)],
                                 dimension_numbers=('NWC', 'WIO', 'NWC'),
                                 feature_group_count=C_WIDTH)
    u = u + p['conv_b_c'][j]
    u = jax.nn.silu(_layer_norm(u, p['conv_ln_g'][j], p['conv_ln_b'][j]))
    lam_init = 0.8 - 0.6 * math.exp(-0.3 * layer_idx)
    lam = (jnp.exp(jnp.sum(p['lam_q1'][j].astype(F32) * p['lam_k1'][j].astype(F32)))
           - jnp.exp(jnp.sum(p['lam_q2'][j].astype(F32) * p['lam_k2'][j].astype(F32))) + lam_init)
    q = q.reshape(B, L, N_HEADS_D, 2, HEAD_DIM).swapaxes(2, 3)
    k = k.reshape(B, L, N_HEADS_D, 2, HEAD_DIM).swapaxes(2, 3)
    v = v.reshape(B, L, N_HEADS_D, D_V_DIFF)
    od = _diff_attention(q, k, v, lam)
    od = (_rms_norm(od, p['subln_g'][j]) * (1.0 - lam_init)).reshape(B, L, W_DV)
    return jnp.concatenate([u, od], axis=-1) @ p['w_out_cd'][j]


def _trunk(x, c, p):
    cs = jax.nn.silu(c)
    for li in range(DEPTH):
        mod = cs @ p['w_mod'][li] + p['b_mod'][li]
        sh1, sc1, g1, sh2, sc2, g2 = [m[:, None, :] for m in jnp.split(mod, 6, axis=-1)]
        h = _rms_norm(x, p['norm_mix_g'][li]) * (1.0 + sc1) + sh1
        if li % 2 == 0:
            out = _mixer_ab(h, p, li // 2)
        else:
            out = _mixer_cd(h, p, li // 2, li)
        x = x + (1.0 + g1) * out
        h = _rms_norm(x, p['norm_ffn_g'][li]) * (1.0 + sc2) + sh2
        ff = (jax.nn.silu(h @ p['w1'][li]) * (h @ p['w3'][li])) @ p['w2'][li]
        x = x + (1.0 + g2) * ff
    return _rms_norm(x, p['final_g'])


def setup_inputs(seed: int = 0) -> dict:
    key = jax.random.key(seed)
    ks = jax.random.split(key, 32)

    def nrm(k, shape, s):
        return jax.random.normal(k, shape, F32) * s

    D = D_MODEL
    return {
        'x_prompt': nrm(ks[0], (BATCH, SEQ, D), 1.0),
        'x_sample': nrm(ks[1], (DEC_BATCH, DEC_SEQ, D), 1.0),
        'c_prompt': nrm(ks[2], (BATCH, D), 1.0),
        'c_sample': nrm(ks[3], (DEC_BATCH, D), 1.0),
        'w_mod': nrm(ks[4], (DEPTH, D, 6 * D), 0.1 * D ** -0.5),
        'b_mod': nrm(ks[5], (DEPTH, 6 * D), 0.02),
        'norm_mix_g': 1.0 + nrm(ks[6], (DEPTH, D), 0.05),
        'norm_ffn_g': 1.0 + nrm(ks[7], (DEPTH, D), 0.05),
        'w_in_ab': nrm(ks[8], (N_AB, D, AB_IN), D ** -0.5),
        'rpb_a': nrm(ks[9], (N_AB, N_HEADS_A, 2 * NA_ROWS - 1, 2 * NA_COLS - 1), 0.1),
        'qnorm_b': 1.0 + nrm(ks[10], (N_AB, HEAD_DIM), 0.05),
        'knorm_b': 1.0 + nrm(ks[11], (N_AB, HEAD_DIM), 0.05),
        'w_out_ab': nrm(ks[12], (N_AB, AB_OUT, D), AB_OUT ** -0.5),
        'w_in_cd': nrm(ks[13], (N_CD, D, CD_IN), D ** -0.5),
        'conv_w_c': nrm(ks[14], (N_CD, CONV_K, C_WIDTH), CONV_K ** -0.5),
        'conv_b_c': nrm(ks[15], (N_CD, C_WIDTH), 0.02),
        'conv_ln_g': 1.0 + nrm(ks[16], (N_CD, C_WIDTH), 0.05),
        'conv_ln_b': nrm(ks[17], (N_CD, C_WIDTH), 0.02),
        'lam_q1': nrm(ks[18], (N_CD, HEAD_DIM), 0.1),
        'lam_k1': nrm(ks[19], (N_CD, HEAD_DIM), 0.1),
        'lam_q2': nrm(ks[20], (N_CD, HEAD_DIM), 0.1),
        'lam_k2': nrm(ks[21], (N_CD, HEAD_DIM), 0.1),
        'subln_g': 1.0 + nrm(ks[22], (N_CD, D_V_DIFF), 0.05),
        'w_out_cd': nrm(ks[23], (N_CD, CD_OUT, D), CD_OUT ** -0.5),
        'w1': nrm(ks[24], (DEPTH, D, D_FF), D ** -0.5),
        'w3': nrm(ks[25], (DEPTH, D, D_FF), D ** -0.5),
        'w2': nrm(ks[26], (DEPTH, D_FF, D), D_FF ** -0.5),
        'final_g': 1.0 + nrm(ks[27], (D,), 0.05),
    }


def reference(x_prompt, x_sample, c_prompt, c_sample, w_mod, b_mod, norm_mix_g, norm_ffn_g,
              w_in_ab, rpb_a, qnorm_b, knorm_b, w_out_ab, w_in_cd, conv_w_c, conv_b_c,
              conv_ln_g, conv_ln_b, lam_q1, lam_k1, lam_q2, lam_k2, subln_g, w_out_cd,
              w1, w3, w2, final_g):
    params = dict(w_mod=w_mod, b_mod=b_mod, norm_mix_g=norm_mix_g, norm_ffn_g=norm_ffn_g,
                  w_in_ab=w_in_ab, rpb_a=rpb_a, qnorm_b=qnorm_b, knorm_b=knorm_b, w_out_ab=w_out_ab,
                  w_in_cd=w_in_cd, conv_w_c=conv_w_c, conv_b_c=conv_b_c, conv_ln_g=conv_ln_g,
                  conv_ln_b=conv_ln_b, lam_q1=lam_q1, lam_k1=lam_k1, lam_q2=lam_q2, lam_k2=lam_k2,
                  subln_g=subln_g, w_out_cd=w_out_cd, w1=w1, w3=w3, w2=w2, final_g=final_g)
    y_prompt = _trunk(x_prompt, c_prompt, params)
    y_sample = _trunk(x_sample, c_sample, params)
    return (y_prompt, y_sample)
```

```cpp
#include <hip/hip_runtime.h>
#include <hip/hip_cooperative_groups.h>
#include <cstdio>
#include <cstdint>
namespace cg = cooperative_groups;
namespace pg8 {
#define PG8_LAS __attribute__((address_space(3)))
typedef unsigned short bf16_t;
typedef short bf16x8 __attribute__((ext_vector_type(8)));
typedef float f32x4 __attribute__((ext_vector_type(4)));
typedef unsigned u32x4 __attribute__((ext_vector_type(4)));
constexpr int BM = 256, BK = 64, HALF = 128, HTB = HALF * BK * 2  , STAGE_BYTES = 8 * HTB, NXCD = 8, WGM = 8;

__host__ __device__ __forceinline__ int lds_byte(int r, int c) { const int st = (r >> 4) * 2 + (c >> 5), rr = r & 15, cc = c & 31, ob = rr * 64 + cc * 2; return st * 1024 + (ob ^ (((ob >> 9) & 1) << 5)); }
__host__ __device__ __forceinline__ void stage_rc(int b, int& R, int& C) { const int st = b / 1024, sb = b % 1024, swz = sb ^ (((sb >> 9) & 1) << 5); R = (st >> 1) * 16 + swz / 64; C = (st & 1) * 32 + (swz % 64) / 2; }
__host__ __device__ __forceinline__ int perm32(int rho) { const int n = rho >> 4, i = rho & 15; return 8 * (i >> 2) + 4 * n + (i & 3); }

struct Unit { int pm, pn; };
struct Gemm { const bf16_t* A; const bf16_t* Bt; int M, N, K; };

struct StaticOrder {
    int nM, nN, nwg, G, c;
    __host__ __device__ void init(int M, int N, int G_, int c_) { nM = M / BM; nN = N / BM; nwg = nM * nN; G = G_; c = c_; }
    __host__ __device__ bool next(int i, Unit& u) const {
        const long L = (long)i * G + c; if (L >= nwg) return false;
        int wgid = (int)L; { const int q = nwg / NXCD, r = nwg % NXCD, xcd = wgid % NXCD, off = wgid / NXCD; wgid = (xcd < r ? xcd * (q + 1) : r * (q + 1) + (xcd - r) * q) + off; }
        const int nig = WGM * nN, gid = wgid / nig, fm = gid * WGM, gsz = (nM - fm) < WGM ? (nM - fm) : WGM;
        u.pm = fm + ((wgid % nig) % gsz); u.pn = (wgid % nig) / gsz; return true;
    }
    __device__ __forceinline__ void a_ready(const Unit&) const {}
    __device__ __forceinline__ void done(const Unit&) const {}
};

__device__ __forceinline__ unsigned cvt_pk_bf16(float lo, float hi) { unsigned r; asm volatile("v_cvt_pk_bf16_f32 %0, %1, %2" : "=v"(r) : "v"(lo), "v"(hi)); return r; }
typedef float f32x2 __attribute__((ext_vector_type(2)));
template <class Epi, class Sched, bool ALIGN_EPI = false, bool SP2 = false>
__device__ __forceinline__ void gemm_phase(PG8_LAS unsigned char* lds, const Gemm g, const Sched& S, const Epi& E) {
    int tid_ = threadIdx.x; asm volatile("" : "+v"(tid_)); const int tid = tid_, wid = __builtin_amdgcn_readfirstlane(tid >> 6), lane = tid & 63, wr = wid >> 2, wc = wid & 3, fr = lane & 15, fq = lane >> 4;
    const int K = g.K, nt = K / BK;
    unsigned voffA[2], voffB[2];
#pragma unroll
    for (int i = 0; i < 2; ++i) { int R, C; stage_rc(tid * 16 + i * 8192, R, C); const int Rb = Epi::PERM ? ((R & ~31) + perm32(R & 31)) : R;
        voffA[i] = (unsigned)(R * K + C) * 2u; voffB[i] = (unsigned)(Rb * K + C) * 2u; }
    const size_t kstep = (size_t)(BK * 2);
    const size_t hstep = (size_t)HALF * K * 2;
    const size_t tstep = 2 * hstep;
    const unsigned ldsw = (unsigned)wid * 1024u;
    const int aoff = lds_byte(wr * 64 + fr, fq * 8), boff = lds_byte(wc * 32 + fr, fq * 8);
#define PG8_SA(b, h) (((b) * 2 + (h)) * HTB)
#define PG8_SB(b, h) ((4 + (b) * 2 + (h)) * HTB)
#define PG8_STAGE(bufoff, gbase, voff) do { _Pragma("unroll") for (int _i = 0; _i < 2; ++_i) \
        __builtin_amdgcn_global_load_lds((const unsigned*)((const char*)(gbase) + (voff)[_i]), (PG8_LAS unsigned*)(lds + (bufoff) + ldsw + _i * 8192), 16, 0, 0); } while (0)
#define PG8_LDA(dst, b, h) do { _Pragma("unroll") for (int m = 0; m < 4; ++m) _Pragma("unroll") for (int k = 0; k < 2; ++k) dst[m][k] = *(const PG8_LAS bf16x8*)(lds + PG8_SA(b, h) + aoff + m * 2048 + k * 1024); } while (0)
#define PG8_LDB(dst, b, h) do { _Pragma("unroll") for (int n = 0; n < 2; ++n) _Pragma("unroll") for (int k = 0; k < 2; ++k) dst[n][k] = *(const PG8_LAS bf16x8*)(lds + PG8_SB(b, h) + boff + n * 2048 + k * 1024); } while (0)
#define PG8_MMA(ai, bj, At, Bt) do { __builtin_amdgcn_s_setprio(1); _Pragma("unroll") for (int m = 0; m < 4; ++m) _Pragma("unroll") for (int n = 0; n < 2; ++n) _Pragma("unroll") for (int k = 0; k < 2; ++k) \
        acc[ai][bj][m][n] = __builtin_amdgcn_mfma_f32_16x16x32_bf16(Bt[n][k], At[m][k], acc[ai][bj][m][n], 0, 0, 0); __builtin_amdgcn_s_setprio(0); } while (0)
#define PG8_WAIT_V(n) asm volatile("s_waitcnt vmcnt(" #n ")" ::: "memory")
#define PG8_WAIT_L(n) asm volatile("s_waitcnt lgkmcnt(" #n ")" ::: "memory")
#define PG8_BAR __builtin_amdgcn_s_barrier()
#define PG8_SCHED __builtin_amdgcn_sched_barrier(0)
    Unit cur, nxt; int ui = 0;
    if (!S.next(0, cur)) return;
    f32x4 acc[2][2][4][2];
#pragma unroll
    for (int a = 0; a < 2; ++a)
#pragma unroll
        for (int b = 0; b < 2; ++b)
#pragma unroll
            for (int m = 0; m < 4; ++m)
#pragma unroll
                for (int n = 0; n < 2; ++n) acc[a][b][m][n] = (f32x4){0.f, 0.f, 0.f, 0.f};
    bf16x8 At[4][2], B0[2][2], B1[2][2];
    const char* cA = (const char*)g.A + (size_t)cur.pm * tstep; const char* cB = (const char*)g.Bt + (size_t)cur.pn * tstep;
    S.a_ready(cur);
    if constexpr (SP2) {
        PG8_STAGE(PG8_SB(0, 0), cB, voffB); PG8_STAGE(PG8_SB(0, 1), cB + hstep, voffB); PG8_STAGE(PG8_SA(0, 0), cA, voffA); PG8_STAGE(PG8_SA(0, 1), cA + hstep, voffA);
        if (wr == 1) PG8_BAR;
        PG8_WAIT_V(2); PG8_BAR;
        PG8_STAGE(PG8_SB(1, 0), cB + kstep, voffB); PG8_STAGE(PG8_SA(1, 0), cA + kstep, voffA); PG8_STAGE(PG8_SB(1, 1), cB + hstep + kstep, voffB);
        PG8_WAIT_V(6); PG8_BAR;
    } else {
        PG8_STAGE(PG8_SB(0, 0), cB, voffB); PG8_STAGE(PG8_SA(0, 0), cA, voffA); PG8_STAGE(PG8_SB(0, 1), cB + hstep, voffB); PG8_STAGE(PG8_SA(0, 1), cA + hstep, voffA);
        if (wr == 1) PG8_BAR;
        PG8_WAIT_V(4); PG8_BAR;
        PG8_STAGE(PG8_SB(1, 0), cB + kstep, voffB); PG8_STAGE(PG8_SA(1, 0), cA + kstep, voffA); PG8_STAGE(PG8_SB(1, 1), cB + hstep + kstep, voffB);
        PG8_WAIT_V(6); PG8_BAR;
    }
    for (;;) {
        const bool has_next = S.next(ui + 1, nxt);
        const char* nA = has_next ? (const char*)g.A + (size_t)nxt.pm * tstep : cA; const char* nB = has_next ? (const char*)g.Bt + (size_t)nxt.pn * tstep : cB;
        for (int t = 0; t < nt; t += 2) {
            const bool last = (t == nt - 2);
            const char* a1 = cA + (size_t)(t + 1) * kstep;
            const char* a2 = last ? nA : cA + (size_t)(t + 2) * kstep; const char* b2 = last ? nB : cB + (size_t)(t + 2) * kstep;
            const char* a3 = a2 + kstep; const char* b3 = b2 + kstep;
            if (last && has_next) S.a_ready(nxt);
            if constexpr (SP2) {
            PG8_LDB(B0, 0, 0); PG8_LDB(B1, 0, 1); PG8_SCHED; PG8_LDA(At, 0, 0); PG8_STAGE(PG8_SA(1, 1), a1 + hstep, voffA);
            PG8_WAIT_V(8); PG8_WAIT_L(0); PG8_BAR; PG8_MMA(0, 0, At, B0); PG8_MMA(0, 1, At, B1); PG8_BAR; PG8_SCHED;
            PG8_LDA(At, 0, 1); PG8_STAGE(PG8_SB(0, 0), b2, voffB); PG8_STAGE(PG8_SB(0, 1), b2 + hstep, voffB); PG8_STAGE(PG8_SA(0, 0), a2, voffA);
            PG8_WAIT_V(8); PG8_WAIT_L(0); PG8_BAR; PG8_MMA(1, 0, At, B0); PG8_MMA(1, 1, At, B1); PG8_BAR; PG8_SCHED;
            PG8_LDB(B0, 1, 0); PG8_LDB(B1, 1, 1); PG8_SCHED; PG8_LDA(At, 1, 0); PG8_STAGE(PG8_SA(0, 1), a2 + hstep, voffA);
            PG8_WAIT_V(8); PG8_WAIT_L(0); PG8_BAR; PG8_MMA(0, 0, At, B0); PG8_MMA(0, 1, At, B1); PG8_BAR; PG8_SCHED;
            PG8_LDA(At, 1, 1); PG8_STAGE(PG8_SB(1, 0), b3, voffB); PG8_STAGE(PG8_SB(1, 1), b3 + hstep, voffB); PG8_STAGE(PG8_SA(1, 0), a3, voffA);
            PG8_WAIT_V(8); PG8_WAIT_L(0); PG8_BAR; PG8_MMA(1, 0, At, B0); PG8_MMA(1, 1, At, B1); PG8_BAR; PG8_SCHED;
            } else {
            PG8_LDB(B0, 0, 0); PG8_SCHED; PG8_LDA(At, 0, 0); PG8_STAGE(PG8_SA(1, 1), a1 + hstep, voffA);
            PG8_WAIT_L(8); PG8_BAR; PG8_WAIT_L(0); PG8_MMA(0, 0, At, B0); PG8_BAR; PG8_SCHED;
            PG8_LDB(B1, 0, 1); PG8_STAGE(PG8_SB(0, 0), b2, voffB);
            PG8_BAR; PG8_WAIT_L(0); PG8_MMA(0, 1, At, B1); PG8_BAR;
            PG8_LDA(At, 0, 1); PG8_STAGE(PG8_SA(0, 0), a2, voffA);
            PG8_BAR; PG8_WAIT_L(0); PG8_MMA(1, 0, At, B0); PG8_BAR; PG8_SCHED;
            PG8_STAGE(PG8_SB(0, 1), b2 + hstep, voffB);
            PG8_WAIT_V(6); PG8_BAR; PG8_MMA(1, 1, At, B1); PG8_BAR;
            PG8_LDB(B0, 1, 0); PG8_SCHED; PG8_LDA(At, 1, 0); PG8_STAGE(PG8_SA(0, 1), a2 + hstep, voffA);
            PG8_WAIT_L(8); PG8_BAR; PG8_WAIT_L(0); PG8_MMA(0, 0, At, B0); PG8_BAR; PG8_SCHED;
            PG8_LDB(B1, 1, 1); PG8_STAGE(PG8_SB(1, 0), b3, voffB);
            PG8_BAR; PG8_WAIT_L(0); PG8_MMA(0, 1, At, B1); PG8_BAR;
            PG8_LDA(At, 1, 1); PG8_STAGE(PG8_SA(1, 0), a3, voffA);
            PG8_BAR; PG8_WAIT_L(0); PG8_MMA(1, 0, At, B0); PG8_BAR; PG8_SCHED;
            PG8_STAGE(PG8_SB(1, 1), b3 + hstep, voffB);
            PG8_WAIT_V(6); PG8_BAR; PG8_MMA(1, 1, At, B1); PG8_BAR;
            }
        }
        if constexpr (ALIGN_EPI) { if (wr == 0) PG8_BAR; }
        if constexpr (!Epi::AFTER_DRAIN) { E(acc, cur, wr, wc, fr, fq); S.done(cur); }
        if (!has_next) break;
#pragma unroll
        for (int a = 0; a < 2; ++a)
#pragma unroll
            for (int b = 0; b < 2; ++b)
#pragma unroll
                for (int m = 0; m < 4; ++m)
#pragma unroll
                    for (int n = 0; n < 2; ++n) acc[a][b][m][n] = (f32x4){0.f, 0.f, 0.f, 0.f};
        cur = nxt; cA = nA; cB = nB; ++ui;
        if constexpr (ALIGN_EPI) { if (wr == 1) PG8_BAR; }
    }
    PG8_WAIT_V(0);
    if constexpr (!ALIGN_EPI) { if (wr == 0) PG8_BAR; }
    PG8_BAR;
    if constexpr (Epi::AFTER_DRAIN) { E.fused(acc, cur, wr, wc, fr, fq, lds, wid, lane); S.done(cur); }
#undef PG8_SA
#undef PG8_SB
#undef PG8_STAGE
#undef PG8_LDA
#undef PG8_LDB
#undef PG8_MMA
#undef PG8_WAIT_V
#undef PG8_WAIT_L
#undef PG8_BAR
#undef PG8_SCHED
}
}

#ifdef TA
constexpr bool defined_TA = true;
#else
constexpr bool defined_TA = false;
#endif
#ifdef TB
constexpr bool defined_TB = true;
#else
constexpr bool defined_TB = false;
#endif
#define LAS __attribute__((address_space(3)))
typedef unsigned short bf16_t;
typedef short bf16x8 __attribute__((ext_vector_type(8)));
typedef short s16x4 __attribute__((ext_vector_type(4)));
typedef float f32x4 __attribute__((ext_vector_type(4)));
typedef float f32x16 __attribute__((ext_vector_type(16)));
typedef unsigned u32x4 __attribute__((ext_vector_type(4)));
typedef unsigned u32x2 __attribute__((ext_vector_type(2)));
using pg8::Unit;

constexpr int T_ALL = 49152, T_PROMPT = 32768, L_P = 4096, L_S = 16384, DM = 1024, DFF = 2816, NBATCH = 9;
constexpr int AB_IN = 2304, CD_IN = 2560;
constexpr float C2 = 0.18033688011112042f;
constexpr float LOG2E = 1.4426950408889634f;
constexpr int NPHASE = 31;

__device__ __forceinline__ int otid() { int t = threadIdx.x; asm volatile("" : "+v"(t)); return t; }
__device__ __forceinline__ int batch_of(int row) { return row < T_PROMPT ? (row >> 12) : 8; }
__device__ __forceinline__ int seq0_of(int b) { return b < 8 ? b * L_P : T_PROMPT; }
__device__ __forceinline__ int seqlen_of(int b) { return b < 8 ? L_P : L_S; }
__device__ __forceinline__ unsigned pk_bf16(float lo, float hi) {
    typedef float f2_t __attribute__((ext_vector_type(2))); typedef __bf16 b2_t __attribute__((ext_vector_type(2)));
    f2_t v = {lo, hi}; b2_t b = __builtin_convertvector(v, b2_t); return __builtin_bit_cast(unsigned, b);
}
__device__ __forceinline__ bf16_t f2bf(float x) { return (bf16_t)(pk_bf16(x, 0.f) & 0xffffu); }
__device__ __forceinline__ float bf2f(bf16_t v) { return __uint_as_float((unsigned)v << 16); }
__device__ __forceinline__ float wave_sum(float v) {
#pragma unroll
    for (int o = 1; o < 64; o <<= 1) v += __shfl_xor(v, o);
    return v;
}
__device__ __forceinline__ float fast_exp2(float x) { return __builtin_amdgcn_exp2f(x); }
__device__ __forceinline__ float silu_f(float a) { return a * __builtin_amdgcn_rcpf(1.f + fast_exp2(-a * LOG2E)); }

constexpr size_t MiB = 1u << 20;
constexpr size_t WS_MOD = 1 * MiB;
constexpr size_t WS_BAR = 65536;
constexpr size_t WS_ROPE = 2 * MiB;
constexpr size_t WS_W = 4 * MiB;
constexpr size_t SZ_WINAB = (size_t)AB_IN * DM * 2, SZ_WOUT = (size_t)DM * DM * 2, SZ_WINCD = (size_t)CD_IN * DM * 2, SZ_W13 = (size_t)2 * DFF * DM * 2, SZ_W2 = (size_t)DM * DFF * 2;
constexpr size_t WS_WINAB = WS_W, WS_WOUTAB = WS_WINAB + 2 * SZ_WINAB, WS_WINCD = WS_WOUTAB + 2 * SZ_WOUT, WS_WOUTCD = WS_WINCD + 2 * SZ_WINCD,
                 WS_W13 = WS_WOUTCD + 2 * SZ_WOUT, WS_W2 = WS_W13 + 4 * SZ_W13, WS_WEND = WS_W2 + 4 * SZ_W2;
static_assert(WS_WEND <= 100 * MiB, "weights region");
constexpr size_t WS_H = 100 * MiB;
constexpr size_t WS_Z = 196 * MiB;
constexpr size_t WS_STASH = 460 * MiB;
constexpr size_t WS_NEED = 492 * MiB;

constexpr int LDS_BYTES = 131072 + 1024;

struct Args { const float* in[28]; float* out; unsigned char* ws; int ph_lo, ph_hi; };

struct EpiInAB {
    static constexpr bool PERM = true, AFTER_DRAIN = false;
    bf16_t* Z; const float* qg; const float* kg; const float* rope;
    __device__ __forceinline__ void operator()(const f32x4 (&acc)[2][2][4][2], const Unit& u, int wr, int wc, int fr, int fq) const {
        const int pn = u.pn;
        const int lcol = pn * 256 + wc * 64 + fq * 8;
        const bool isq = (pn == 6 || pn == 7), isk = (pn == 8 && wc < 2);
        const float* gsrc = isq ? qg : kg;
        f32x4 gv[2][2];
#pragma unroll
        for (int bj = 0; bj < 2; ++bj)
#pragma unroll
            for (int n = 0; n < 2; ++n) gv[bj][n] = *(const f32x4*)(gsrc + bj * 32 + fq * 8 + n * 4);
        const float qs = (pn < 2 || isq) ? C2 : 1.f;
#pragma unroll
        for (int ai = 0; ai < 2; ++ai)
#pragma unroll
            for (int m = 0; m < 4; ++m) {
                const int row = u.pm * 256 + ai * 128 + wr * 64 + m * 16 + fr;
                f32x4 v[2][2];
#pragma unroll
                for (int bj = 0; bj < 2; ++bj)
#pragma unroll
                    for (int n = 0; n < 2; ++n) v[bj][n] = acc[ai][bj][m][n];
                if (isq || isk) {
                    float ss = 0.f;
#pragma unroll
                    for (int bj = 0; bj < 2; ++bj)
#pragma unroll
                        for (int n = 0; n < 2; ++n) ss += (v[bj][n][0] * v[bj][n][0] + v[bj][n][1] * v[bj][n][1]) + (v[bj][n][2] * v[bj][n][2] + v[bj][n][3] * v[bj][n][3]);
                    ss += __shfl_xor(ss, 16); ss += __shfl_xor(ss, 32);
                    const float rstd = __builtin_amdgcn_rsqf(ss * (1.f / 64.f) + 1e-6f);
                    const int t = row < T_PROMPT ? (row & (L_P - 1)) : (row - T_PROMPT);
                    const int prow = t >> 6, pcol = t & 63;
#pragma unroll
                    for (int bj = 0; bj < 2; ++bj) {
                        const float* rp = rope + ((bj == 0 ? prow : pcol) * 16 + fq * 4) * 2;
#pragma unroll
                        for (int n = 0; n < 2; ++n) {
                            const f32x4 cs = *(const f32x4*)(rp + n * 4);
                            const f32x4 y = v[bj][n] * rstd * gv[bj][n];
                            f32x4 o;
                            o[0] = y[0] * cs[0] - y[1] * cs[1]; o[1] = y[0] * cs[1] + y[1] * cs[0];
                            o[2] = y[2] * cs[2] - y[3] * cs[3]; o[3] = y[2] * cs[3] + y[3] * cs[2];
                            v[bj][n] = o;
                        }
                    }
                }
                bf16_t* zp = Z + (size_t)row * AB_IN + lcol;
#pragma unroll
                for (int bj = 0; bj < 2; ++bj) {
                    const f32x4 a = v[bj][0] * qs, b = v[bj][1] * qs;
                    u32x4 w; w.x = pk_bf16(a[0], a[1]); w.y = pk_bf16(a[2], a[3]); w.z = pk_bf16(b[0], b[1]); w.w = pk_bf16(b[2], b[3]);
                    *(u32x4*)(zp + bj * 32) = w;
                }
            }
    }
};
struct EpiInCD {
    static constexpr bool PERM = true, AFTER_DRAIN = false;
    bf16_t* Z; unsigned* nrm;
    __device__ __forceinline__ void operator()(const f32x4 (&acc)[2][2][4][2], const Unit& u, int wr, int wc, int fr, int fq) const {
        const int pn = u.pn;
        const int lcol = pn * 256 + wc * 64 + fq * 8;
        const float qs = (pn == 4 || pn == 5) ? C2 : 1.f;
        if (pn >= 4 && pn < 8) {
            float mx = 0.f;
#pragma unroll
            for (int ai = 0; ai < 2; ++ai)
#pragma unroll
                for (int m = 0; m < 4; ++m) {
                    float ss = 0.f;
#pragma unroll
                    for (int bj = 0; bj < 2; ++bj)
#pragma unroll
                        for (int n = 0; n < 2; ++n) { const f32x4 v = acc[ai][bj][m][n] * qs; ss += (v[0] * v[0] + v[1] * v[1]) + (v[2] * v[2] + v[3] * v[3]); }
                    ss += __shfl_xor(ss, 16); ss += __shfl_xor(ss, 32);
                    mx = fmaxf(mx, ss);
                }
            mx = fmaxf(mx, __shfl_xor(mx, 1)); mx = fmaxf(mx, __shfl_xor(mx, 2)); mx = fmaxf(mx, __shfl_xor(mx, 4)); mx = fmaxf(mx, __shfl_xor(mx, 8));
            if (fr == 0 && fq == 0) atomicMax(nrm + (pn - 4) * 4 + wc, __float_as_uint(mx));
        }
#pragma unroll
        for (int ai = 0; ai < 2; ++ai)
#pragma unroll
            for (int m = 0; m < 4; ++m) {
                const int row = u.pm * 256 + ai * 128 + wr * 64 + m * 16 + fr;
                bf16_t* zp = Z + (size_t)row * CD_IN + lcol;
#pragma unroll
                for (int bj = 0; bj < 2; ++bj) {
                    const f32x4 a = acc[ai][bj][m][0] * qs, b = acc[ai][bj][m][1] * qs;
                    u32x4 w; w.x = pk_bf16(a[0], a[1]); w.y = pk_bf16(a[2], a[3]); w.z = pk_bf16(b[0], b[1]); w.w = pk_bf16(b[2], b[3]);
                    *(u32x4*)(zp + bj * 32) = w;
                }
            }
    }
};
template <bool FIRST>
struct EpiRes {
    static constexpr bool PERM = true, AFTER_DRAIN = false;
    const float* base_p; const float* base_s; bf16_t* xb; const float* gate;
    bf16_t* xw;
    __device__ __forceinline__ void operator()(const f32x4 (&acc)[2][2][4][2], const Unit& u, int wr, int wc, int fr, int fq) const {
        const int col0 = u.pn * 256 + wc * 32 + fq * 8;
        const int b = batch_of(u.pm * 256);
        const float* gp = gate + b * 6144 + col0;
        f32x4 g1[2][2];
#pragma unroll
        for (int bj = 0; bj < 2; ++bj)
#pragma unroll
            for (int n = 0; n < 2; ++n) g1[bj][n] = *(const f32x4*)(gp + bj * 128 + n * 4) + 1.f;
#pragma unroll
        for (int ai = 0; ai < 2; ++ai) {
            const int row0 = u.pm * 256 + ai * 128 + wr * 64 + fr;
            bf16_t* op = xb + (size_t)row0 * DM + col0; bf16_t* ow = xw + (size_t)row0 * DM + col0;
            if constexpr (FIRST) {
                const float* bp = (row0 < T_PROMPT ? base_p + (size_t)row0 * DM : base_s + (size_t)(row0 - T_PROMPT) * DM) + col0;
#pragma unroll
                for (int mh = 0; mh < 4; mh += 2) {
                    f32x4 xv[2][2][2];
#pragma unroll
                    for (int m = 0; m < 2; ++m)
#pragma unroll
                        for (int bj = 0; bj < 2; ++bj)
#pragma unroll
                            for (int n = 0; n < 2; ++n) xv[m][bj][n] = *(const f32x4*)(bp + (size_t)((mh + m) * 16) * DM + bj * 128 + n * 4);
#pragma unroll
                    for (int m = 0; m < 2; ++m)
#pragma unroll
                        for (int bj = 0; bj < 2; ++bj) {
                            const f32x4 a = xv[m][bj][0] + g1[bj][0] * acc[ai][bj][mh + m][0], c = xv[m][bj][1] + g1[bj][1] * acc[ai][bj][mh + m][1];
                            u32x4 w; w.x = pk_bf16(a[0], a[1]); w.y = pk_bf16(a[2], a[3]); w.z = pk_bf16(c[0], c[1]); w.w = pk_bf16(c[2], c[3]);
                            *(u32x4*)(ow + (size_t)((mh + m) * 16) * DM + bj * 128) = w;
                        }
                }
            } else {
                u32x4 xv[4][2];
#pragma unroll
                for (int m = 0; m < 4; ++m)
#pragma unroll
                    for (int bj = 0; bj < 2; ++bj) xv[m][bj] = *(const u32x4*)(op + (size_t)(m * 16) * DM + bj * 128);
#pragma unroll
                for (int m = 0; m < 4; ++m)
#pragma unroll
                    for (int bj = 0; bj < 2; ++bj) {
                        const u32x4 x = xv[m][bj];
                        const f32x4 x0 = {__uint_as_float(x.x << 16), __uint_as_float(x.x & 0xffff0000u), __uint_as_float(x.y << 16), __uint_as_float(x.y & 0xffff0000u)};
                        const f32x4 x1 = {__uint_as_float(x.z << 16), __uint_as_float(x.z & 0xffff0000u), __uint_as_float(x.w << 16), __uint_as_float(x.w & 0xffff0000u)};
                        const f32x4 a = x0 + g1[bj][0] * acc[ai][bj][m][0], c = x1 + g1[bj][1] * acc[ai][bj][m][1];
                        u32x4 w; w.x = pk_bf16(a[0], a[1]); w.y = pk_bf16(a[2], a[3]); w.z = pk_bf16(c[0], c[1]); w.w = pk_bf16(c[2], c[3]);
                        *(u32x4*)(ow + (size_t)(m * 16) * DM + bj * 128) = w;
                    }
            }
        }
    }
};
struct EpiResAt {
    static constexpr bool PERM = true, AFTER_DRAIN = false;
    float* out; const float* gate;
    __device__ __forceinline__ void operator()(const f32x4 (&acc)[2][2][4][2], const Unit& u, int wr, int wc, int fr, int fq) const {
        const int col0 = u.pn * 256 + wc * 32 + fq * 8;
        const int b = batch_of(u.pm * 256);
        const float* gp = gate + b * 6144 + col0;
        f32x4 g1[2][2];
#pragma unroll
        for (int bj = 0; bj < 2; ++bj)
#pragma unroll
            for (int n = 0; n < 2; ++n) g1[bj][n] = *(const f32x4*)(gp + bj * 128 + n * 4) + 1.f;
#pragma unroll
        for (int ai = 0; ai < 2; ++ai)
#pragma unroll
            for (int m = 0; m < 4; ++m) {
                float* op = out + (size_t)(u.pm * 256 + ai * 128 + wr * 64 + m * 16 + fr) * DM + col0;
#pragma unroll
                for (int bj = 0; bj < 2; ++bj)
#pragma unroll
                    for (int n = 0; n < 2; ++n) {
                        const f32x4 v = g1[bj][n] * acc[ai][bj][m][n];
#pragma unroll
                        for (int e = 0; e < 4; ++e) unsafeAtomicAdd(op + bj * 128 + n * 4 + e, v[e]);
                    }
            }
    }
};
struct EpiUp {
    static constexpr bool PERM = true, AFTER_DRAIN = false;
    bf16_t* U;
    __device__ __forceinline__ void operator()(const f32x4 (&acc)[2][2][4][2], const Unit& u, int wr, int wc, int fr, int fq) const {
        const int col0 = u.pn * 128 + wc * 32 + fq * 8;
#pragma unroll
        for (int ai = 0; ai < 2; ++ai)
#pragma unroll
            for (int m = 0; m < 4; ++m) {
                const int row = u.pm * 256 + ai * 128 + wr * 64 + m * 16 + fr;
                f32x4 r[2];
#pragma unroll
                for (int n = 0; n < 2; ++n) {
                    const f32x4 a = acc[ai][0][m][n], g = acc[ai][1][m][n];
                    r[n][0] = silu_f(a[0]) * g[0]; r[n][1] = silu_f(a[1]) * g[1]; r[n][2] = silu_f(a[2]) * g[2]; r[n][3] = silu_f(a[3]) * g[3];
                }
                u32x4 w; w.x = pk_bf16(r[0][0], r[0][1]); w.y = pk_bf16(r[0][2], r[0][3]); w.z = pk_bf16(r[1][0], r[1][1]); w.w = pk_bf16(r[1][2], r[1][3]);
                *(u32x4*)(U + (size_t)row * DFF + col0) = w;
            }
    }
};

constexpr int KBUF = 8192, ATT_TAB = 65536;
#ifndef PIPE128
#define PIPE128 1
#endif
__device__ __forceinline__ s16x4 tr_read(const LAS unsigned char* p) {
    typedef short v4i16_t __attribute__((ext_vector_type(4)));
    return __builtin_bit_cast(s16x4, __builtin_amdgcn_ds_read_tr16_b64_v4i16((LAS v4i16_t*)p));
}
__device__ __forceinline__ int crow(int r, int hi) { return (r & 3) + 8 * (r >> 2) + 4 * hi; }

__device__ __forceinline__ void glds16(const void* gsrc, unsigned lds_dst) {
    unsigned keep;
    asm volatile("s_mov_b32 %0, m0\n\ts_mov_b32 m0, %2\n\ts_nop 0\n\tglobal_load_lds_dwordx4 %1, off\n\ts_mov_b32 m0, %0" : "=&s"(keep) : "v"(gsrc), "s"(lds_dst) : "memory");
}
template <bool SPLIT>
__device__ __forceinline__ void qk_tile(const LAS unsigned char* Ks, const bf16x8 (&qr)[4], f32x16& s0, f32x16& s1) {
    const f32x16 zero16 = {0.f, 0.f, 0.f, 0.f, 0.f, 0.f, 0.f, 0.f, 0.f, 0.f, 0.f, 0.f, 0.f, 0.f, 0.f, 0.f};
    s0 = zero16; s1 = zero16;
#pragma unroll
    for (int d0 = 0; d0 < 4; ++d0) {
        const bf16x8 b0 = *(const LAS bf16x8*)(Ks + d0 * 256);
        const bf16x8 b1 = *(const LAS bf16x8*)(Ks + d0 * 256 + 4096);
        s0 = __builtin_amdgcn_mfma_f32_32x32x16_bf16(b0, qr[d0], s0, 0, 0, 0);
        s1 = __builtin_amdgcn_mfma_f32_32x32x16_bf16(b1, qr[d0], s1, 0, 0, 0);
        if (SPLIT && d0 == 1) __builtin_amdgcn_sched_barrier(0);
    }
}
__device__ __forceinline__ void qk_tile_c(const LAS unsigned char* Ks, const bf16x8 (&qr)[4], f32x16& s0, f32x16& s1, const f32x16& cinit) {
#pragma unroll
    for (int d0 = 0; d0 < 4; ++d0) {
        const bf16x8 b0 = *(const LAS bf16x8*)(Ks + d0 * 256);
        const bf16x8 b1 = *(const LAS bf16x8*)(Ks + d0 * 256 + 4096);
        s0 = __builtin_amdgcn_mfma_f32_32x32x16_bf16(b0, qr[d0], d0 == 0 ? cinit : s0, 0, 0, 0);
        s1 = __builtin_amdgcn_mfma_f32_32x32x16_bf16(b1, qr[d0], d0 == 0 ? cinit : s1, 0, 0, 0);
    }
}
template <int MODE>
__device__ __forceinline__ void apply_bias(f32x16& s0, f32x16& s1, int t, int hi, float slope2, int qpos, const LAS float* na_tab, int na_d0, int na_qc, int na_cs) {
    if constexpr (MODE == 1 && !defined_TA) {
        const float kbf = (float)(t * 64 + 4 * hi - qpos);
#pragma unroll
        for (int i = 0; i < 16; ++i) {
            const float c = (float)((i & 3) + 8 * (i >> 2));
            s0[i] = fmaf(-slope2, fabsf(kbf + c), s0[i]);
            s1[i] = fmaf(-slope2, fabsf(kbf + (c + 32.f)), s1[i]);
        }
    }
    if constexpr (MODE == 2) {
        const volatile LAS float* tb = na_tab + (t + na_d0) * 31 + (79 - na_qc + 4 * hi);
        const int cb = 4 * hi - na_cs;
        float bv0[16], bv1[16];
#pragma unroll
        for (int i = 0; i < 16; ++i) { const int c = (i & 3) + 8 * (i >> 2); bv0[i] = tb[c]; bv1[i] = tb[c + 32]; }
#pragma unroll
        for (int i = 0; i < 16; ++i) {
            const int c = (i & 3) + 8 * (i >> 2);
            s0[i] = ((unsigned)(cb + c) < 16u) ? s0[i] + bv0[i] : -1e30f;
            s1[i] = ((unsigned)(cb + c + 32) < 16u) ? s1[i] + bv1[i] : -1e30f;
        }
    }
}
template <int NDB>
__device__ __forceinline__ void max_rescale(f32x16& s0, f32x16& s1, f32x16 (&o)[NDB], float& mref, float& lacc, int hi) {
    constexpr float THR = 6.f;
#pragma unroll
    for (int i = 0; i < 16; ++i) { s0[i] -= mref; s1[i] -= mref; }
    float ra = fmaxf(fmaxf(s0[0], s1[0]), s0[1]), rb = fmaxf(fmaxf(s1[1], s0[2]), s1[2]);
#pragma unroll
    for (int i = 3; i < 15; i += 2) { ra = fmaxf(fmaxf(ra, s0[i]), s1[i]); rb = fmaxf(fmaxf(rb, s0[i + 1]), s1[i + 1]); }
    float rm = fmaxf(fmaxf(ra, rb), fmaxf(s0[15], s1[15]));
    rm = fmaxf(rm, __shfl_xor(rm, 32));
    if (__any(rm > THR)) {
        const float dl = fmaxf(rm, 0.f);
        const float f = fast_exp2(-dl);
        lacc *= f; mref += dl;
#pragma unroll
        for (int i = 0; i < 16; ++i) { s0[i] -= dl; s1[i] -= dl; }
#pragma unroll
        for (int r = 0; r < 16; ++r) {
            const float fq_ = __shfl(f, crow(r, hi));
#pragma unroll
            for (int d = 0; d < NDB; ++d) o[d][r] *= fq_;
        }
    }
}
template <int NDB>
__device__ __forceinline__ void max_rescale_c(f32x16& s0, f32x16& s1, f32x16 (&o)[NDB], float& mref, float& lacc, int hi, f32x16& negm) {
    constexpr float THR = 6.f;
    float ra = fmaxf(fmaxf(s0[0], s1[0]), s0[1]), rb = fmaxf(fmaxf(s1[1], s0[2]), s1[2]);
#pragma unroll
    for (int i = 3; i < 15; i += 2) { ra = fmaxf(fmaxf(ra, s0[i]), s1[i]); rb = fmaxf(fmaxf(rb, s0[i + 1]), s1[i + 1]); }
    float rm = fmaxf(fmaxf(ra, rb), fmaxf(s0[15], s1[15]));
    rm = fmaxf(rm, __shfl_xor(rm, 32));
    if (__any(rm > THR)) {
        const float dl = fmaxf(rm, 0.f);
        const float f = fast_exp2(-dl);
        lacc *= f; mref += dl;
#pragma unroll
        for (int i = 0; i < 16; ++i) { s0[i] -= dl; s1[i] -= dl; negm[i] = -mref; }
        asm volatile("" : "+v"(negm));
#pragma unroll
        for (int r = 0; r < 16; ++r) {
            const float fq_ = __shfl(f, crow(r, hi));
#pragma unroll
            for (int d = 0; d < NDB; ++d) o[d][r] *= fq_;
        }
    }
}
template <int NDB>
__device__ __forceinline__ void softmax_pv(const LAS unsigned char* Vs, f32x16& s0, f32x16& s1, f32x16 (&o)[NDB], float& lacc) {
    float sum = 0.f;
#pragma unroll
    for (int i = 0; i < 16; ++i) { s0[i] = fast_exp2(s0[i]); s1[i] = fast_exp2(s1[i]); sum += s0[i] + s1[i]; }
    lacc += sum;
    bf16x8 pa[4];
    {
        u32x4 w;
        w.x = pk_bf16(s0[0], s0[1]); w.y = pk_bf16(s0[2], s0[3]); w.z = pk_bf16(s0[4], s0[5]); w.w = pk_bf16(s0[6], s0[7]); pa[0] = __builtin_bit_cast(bf16x8, w);
        w.x = pk_bf16(s0[8], s0[9]); w.y = pk_bf16(s0[10], s0[11]); w.z = pk_bf16(s0[12], s0[13]); w.w = pk_bf16(s0[14], s0[15]); pa[1] = __builtin_bit_cast(bf16x8, w);
        w.x = pk_bf16(s1[0], s1[1]); w.y = pk_bf16(s1[2], s1[3]); w.z = pk_bf16(s1[4], s1[5]); w.w = pk_bf16(s1[6], s1[7]); pa[2] = __builtin_bit_cast(bf16x8, w);
        w.x = pk_bf16(s1[8], s1[9]); w.y = pk_bf16(s1[10], s1[11]); w.z = pk_bf16(s1[12], s1[13]); w.w = pk_bf16(s1[14], s1[15]); pa[3] = __builtin_bit_cast(bf16x8, w);
    }
#pragma unroll
    for (int db = 0; db < NDB; ++db) {
#pragma unroll
        for (int i = 0; i < 4; ++i) {
            const s16x4 lo = tr_read(Vs + db * 4096 + i * 1024);
            const s16x4 hi4 = tr_read(Vs + db * 4096 + i * 1024 + 512);
            const bf16x8 vf = {lo[0], lo[1], lo[2], lo[3], hi4[0], hi4[1], hi4[2], hi4[3]};
            o[db] = __builtin_amdgcn_mfma_f32_32x32x16_bf16(pa[i], vf, o[db], 0, 0, 0);
        }
    }
}

template <int NOMAX>
__device__ __forceinline__ void step_hs(const LAS unsigned char* Ks, const LAS unsigned char* Vs, const bf16x8 (&qr)[4], f32x16& C0, f32x16& C1, f32x16& N0, f32x16& N1,
                                        f32x16 (&o)[2], float& mref, float& lacc, int hi, f32x16& negm) {
#define SBAR() __builtin_amdgcn_sched_barrier(0)
    bf16x8 kf[8];
#pragma unroll
    for (int c = 0; c < 8; ++c) kf[c] = *(const LAS bf16x8*)(Ks + (c & 3) * 256 + (c >> 2) * 4096);
    unsigned pw[16]; float sum = 0.f;
#define EXP2P(C, e, w) do { const float e0_ = fast_exp2(C[e]), e1_ = fast_exp2(C[(e) + 1]); sum += e0_ + e1_; pw[w] = pk_bf16(e0_, e1_); } while (0)
    SBAR();
#pragma unroll
    for (int j = 0; j < 8; ++j) {
        if (j < 4) N0 = __builtin_amdgcn_mfma_f32_32x32x16_bf16(kf[j], qr[j], j == 0 ? negm : N0, 0, 0, 0);
        else       N1 = __builtin_amdgcn_mfma_f32_32x32x16_bf16(kf[j], qr[j - 4], j == 4 ? negm : N1, 0, 0, 0);
        EXP2P(C0, 2 * j, j);
        SBAR();
    }
    s16x4 vlo[8], vhi[8];
#pragma unroll
    for (int j = 0; j < 4; ++j) { vlo[j] = tr_read(Vs + (j & 1) * 4096 + (j >> 1) * 1024); vhi[j] = tr_read(Vs + (j & 1) * 4096 + (j >> 1) * 1024 + 512); }
    float ra = -3.0e38f, rb = -3.0e38f;
    SBAR();
#pragma unroll
    for (int j = 0; j < 8; ++j) {
        if (j + 4 < 8) { const int jj = j + 4; vlo[jj] = tr_read(Vs + (jj & 1) * 4096 + (jj >> 1) * 1024); vhi[jj] = tr_read(Vs + (jj & 1) * 4096 + (jj >> 1) * 1024 + 512); }
        const bf16x8 vf = {vlo[j][0], vlo[j][1], vlo[j][2], vlo[j][3], vhi[j][0], vhi[j][1], vhi[j][2], vhi[j][3]};
        const int i = j >> 1;
        const u32x4 w = {pw[4 * i], pw[4 * i + 1], pw[4 * i + 2], pw[4 * i + 3]};
        const bf16x8 pa = __builtin_bit_cast(bf16x8, w);
        if (j & 1) o[1] = __builtin_amdgcn_mfma_f32_32x32x16_bf16(pa, vf, o[1], 0, 0, 0);
        else       o[0] = __builtin_amdgcn_mfma_f32_32x32x16_bf16(pa, vf, o[0], 0, 0, 0);
        if (j < 4) EXP2P(C1, 2 * j, 8 + j);
        if (j >= 2 && j < 6) EXP2P(C1, 8 + 2 * (j - 2), 12 + (j - 2));
        const int bs = (j & 3) * 4;
        if constexpr (!NOMAX) {
        if (j < 4) { ra = fmaxf(fmaxf(ra, N0[bs]), N0[bs + 1]); rb = fmaxf(fmaxf(rb, N0[bs + 2]), N0[bs + 3]); }
        else       { ra = fmaxf(fmaxf(ra, N1[bs]), N1[bs + 1]); rb = fmaxf(fmaxf(rb, N1[bs + 2]), N1[bs + 3]); }
        }
        SBAR();
    }
    lacc += sum;
#undef EXP2P
    if constexpr (NOMAX) return;
    float rm = fmaxf(ra, rb);
    rm = fmaxf(rm, __shfl_xor(rm, 32));
    if (__any(rm > 6.f)) {
        const float dl = fmaxf(rm, 0.f);
        const float f = fast_exp2(-dl);
        lacc *= f; mref += dl;
#pragma unroll
        for (int i = 0; i < 16; ++i) { N0[i] -= dl; N1[i] -= dl; negm[i] = -mref; }
        asm volatile("" : "+v"(negm));
#pragma unroll
        for (int r = 0; r < 16; ++r) {
            const float fq_ = __shfl(f, crow(r, hi));
            o[0][r] *= fq_; o[1][r] *= fq_;
        }
    }
#undef SBAR
}

__device__ __forceinline__ void step_hs128(const LAS unsigned char* Ks, const LAS unsigned char* Vs, const bf16x8 (&qr)[4], f32x16& C0, f32x16& C1, f32x16& N0, f32x16& N1,
                                           f32x16 (&o)[4], float& mref, float& lacc, int hi, float slope2, int qpos, int tn, f32x16& negm) {
#define SBAR() __builtin_amdgcn_sched_barrier(0)
#define KFRAG(c) (*(const LAS bf16x8*)(Ks + ((c) & 3) * 256 + ((c) >> 2) * 4096))
    bf16x8 kf[8];
    kf[0] = KFRAG(0); kf[1] = KFRAG(1);
    unsigned pw[16]; float sum = 0.f;
    SBAR();
#pragma unroll
    for (int j = 0; j < 8; ++j) {
        if (j + 2 < 8) kf[j + 2] = KFRAG(j + 2);
        if (j < 4) N0 = __builtin_amdgcn_mfma_f32_32x32x16_bf16(kf[j], qr[j], j == 0 ? negm : N0, 0, 0, 0);
        else       N1 = __builtin_amdgcn_mfma_f32_32x32x16_bf16(kf[j], qr[j - 4], j == 4 ? negm : N1, 0, 0, 0);
        const int bs = (j & 3) * 4;
        float e0, e1, e2, e3;
        if (j < 4) { e0 = fast_exp2(C0[bs]); e1 = fast_exp2(C0[bs + 1]); e2 = fast_exp2(C0[bs + 2]); e3 = fast_exp2(C0[bs + 3]); }
        else       { e0 = fast_exp2(C1[bs]); e1 = fast_exp2(C1[bs + 1]); e2 = fast_exp2(C1[bs + 2]); e3 = fast_exp2(C1[bs + 3]); }
        sum += (e0 + e1) + (e2 + e3);
        pw[2 * j] = pk_bf16(e0, e1); pw[2 * j + 1] = pk_bf16(e2, e3);
        SBAR();
    }
    lacc += sum;
    bf16x8 pa[4];
#pragma unroll
    for (int i = 0; i < 4; ++i) { u32x4 w = {pw[4 * i], pw[4 * i + 1], pw[4 * i + 2], pw[4 * i + 3]}; pa[i] = __builtin_bit_cast(bf16x8, w); }
    s16x4 vlo[16], vhi[16];
#define VOFFS(j) (((j) & 3) * 4096 + ((j) >> 2) * 1024)
    vlo[0] = tr_read(Vs + VOFFS(0)); vhi[0] = tr_read(Vs + VOFFS(0) + 512);
    vlo[1] = tr_read(Vs + VOFFS(1)); vhi[1] = tr_read(Vs + VOFFS(1) + 512);
    float ra = -3.0e38f, rb = -3.0e38f;
    const float kbf = (float)(tn * 64 + 4 * hi - qpos);
    SBAR();
#pragma unroll
    for (int j = 0; j < 16; ++j) {
        if (j + 2 < 16) { vlo[j + 2] = tr_read(Vs + VOFFS(j + 2)); vhi[j + 2] = tr_read(Vs + VOFFS(j + 2) + 512); }
        const bf16x8 vf = {vlo[j][0], vlo[j][1], vlo[j][2], vlo[j][3], vhi[j][0], vhi[j][1], vhi[j][2], vhi[j][3]};
        if ((j & 3) == 0)      o[0] = __builtin_amdgcn_mfma_f32_32x32x16_bf16(pa[j >> 2], vf, o[0], 0, 0, 0);
        else if ((j & 3) == 1) o[1] = __builtin_amdgcn_mfma_f32_32x32x16_bf16(pa[j >> 2], vf, o[1], 0, 0, 0);
        else if ((j & 3) == 2) o[2] = __builtin_amdgcn_mfma_f32_32x32x16_bf16(pa[j >> 2], vf, o[2], 0, 0, 0);
        else                   o[3] = __builtin_amdgcn_mfma_f32_32x32x16_bf16(pa[j >> 2], vf, o[3], 0, 0, 0);
        {
            const int e = (2 * j) & 15;
            const float c0 = (float)((e & 3) + 8 * (e >> 2) + (j >= 8 ? 32 : 0)), c1 = (float)(((e + 1) & 3) + 8 * ((e + 1) >> 2) + (j >= 8 ? 32 : 0));
            if (j < 8) {
                N0[e] = fmaf(-slope2, fabsf(kbf + c0), N0[e]); N0[e + 1] = fmaf(-slope2, fabsf(kbf + c1), N0[e + 1]);
                if (j & 1) rb = fmaxf(fmaxf(rb, N0[e]), N0[e + 1]); else ra = fmaxf(fmaxf(ra, N0[e]), N0[e + 1]);
            } else {
                N1[e] = fmaf(-slope2, fabsf(kbf + c0), N1[e]); N1[e + 1] = fmaf(-slope2, fabsf(kbf + c1), N1[e + 1]);
                if (j & 1) rb = fmaxf(fmaxf(rb, N1[e]), N1[e + 1]); else ra = fmaxf(fmaxf(ra, N1[e]), N1[e + 1]);
            }
        }
        SBAR();
    }
    float rm = fmaxf(ra, rb);
    rm = fmaxf(rm, __shfl_xor(rm, 32));
    if (__any(rm > 6.f)) {
        const float dl = fmaxf(rm, 0.f);
        const float f = fast_exp2(-dl);
        lacc *= f; mref += dl;
#pragma unroll
        for (int i = 0; i < 16; ++i) { N0[i] -= dl; N1[i] -= dl; negm[i] = -mref; }
        asm volatile("" : "+v"(negm));
#pragma unroll
        for (int r = 0; r < 16; ++r) {
            const float fq_ = __shfl(f, crow(r, hi));
            o[0][r] *= fq_; o[1][r] *= fq_; o[2][r] *= fq_; o[3][r] *= fq_;
        }
    }
#undef SBAR
#undef KFRAG
#undef VOFFS
}

template <int DV, int MODE, int NMAP, int NOMAX = 0>
__device__ __forceinline__ void flash_core(LAS unsigned char* lds, const bf16_t* __restrict__ Kg, int ldk, const bf16_t* __restrict__ Vg, int ldv, int nt,
                                           const bf16x8 (&qr)[4], f32x16 (&o)[DV / 32], float& ltot,
                                           float slope2, int qpos, int na_tlo, int na_d0, int na_qc) {
    constexpr int NDB = DV / 32, VBUF = DV * 128, KST = NMAP * KBUF, VOFF = 3 * KST, NOPS = NMAP + DV / 64;
    static_assert(NOPS == 2 || NOPS == 4, "counted waits below");
    const int tid = otid(), lane = tid & 63, r32 = lane & 31, hi = lane >> 5, wid = tid >> 6;
    const int mp = NMAP == 2 ? (wid >> 2) : 0;
    const int widu = __builtin_amdgcn_readfirstlane(wid);
    const unsigned lds0 = (unsigned)(uintptr_t)lds;
    const bf16_t* ksrc = Kg + (size_t)(widu * 8 + (lane & 7)) * ldk + ((lane >> 3) ^ ((widu >> 1) & 1)) * 8;
    const bf16_t* vsrc = Vg + (size_t)(16 * (widu & 3) + (lane >> 2)) * ldv + (widu >> 2) * 32 + (lane & 3) * 8;
    const unsigned kdst = lds0 + widu * 1024, vdst = lds0 + VOFF + (widu >> 2) * 4096 + (widu & 3) * 1024;
    const int kro = mp * KBUF + (r32 >> 3) * 1024 + (r32 & 7) * 16 + (hi ^ ((r32 >> 4) & 1)) * 128;
    const int vro = VOFF + (4 * hi + ((lane & 15) >> 2)) * 64 + ((lane >> 4) & 1) * 32 + (lane & 3) * 8;
    const f32x16 zero16 = {0.f, 0.f, 0.f, 0.f, 0.f, 0.f, 0.f, 0.f, 0.f, 0.f, 0.f, 0.f, 0.f, 0.f, 0.f, 0.f};
#pragma unroll
    for (int d = 0; d < NDB; ++d) o[d] = zero16;
    float mref = 0.f, lacc = 0.f;
    const int na_cs = MODE == 2 ? min(max(na_qc - 8, 0), 48) : 0;
    const LAS float* na_tab = (const LAS float*)(lds + ATT_TAB);
    const int ntm1 = nt - 1;
#define FL_DMAK(tt, st) do { const bf16_t* p_ = ksrc + (size_t)min((tt), ntm1) * 64 * ldk; glds16(p_, (unsigned)__builtin_amdgcn_readfirstlane(kdst + (st) * KST)); \
        if constexpr (NMAP == 2) glds16(p_ + 64, (unsigned)__builtin_amdgcn_readfirstlane(kdst + (st) * KST + KBUF)); } while (0)
#define FL_DMAV(tt, st) do { const bf16_t* p_ = vsrc + (size_t)min((tt), ntm1) * 64 * ldv; glds16(p_, (unsigned)__builtin_amdgcn_readfirstlane(vdst + (st) * VBUF)); \
        if constexpr (DV == 128) glds16(p_ + 64, (unsigned)__builtin_amdgcn_readfirstlane(vdst + (st) * VBUF + 8192)); } while (0)
#define FL_WB_ALL() asm volatile("s_waitcnt vmcnt(0) lgkmcnt(0)\n\ts_barrier" ::: "memory")
#define FL_WB_ONE() do { if constexpr (NOPS == 2) asm volatile("s_waitcnt vmcnt(2) lgkmcnt(0)\n\ts_barrier" ::: "memory"); else asm volatile("s_waitcnt vmcnt(4) lgkmcnt(0)\n\ts_barrier" ::: "memory"); } while (0)
#define FL_NEXT(s) ((s) == 2 ? 0 : (s) + 1)
#define FL_ACT(tt) (MODE != 2 || (unsigned)((tt) - na_tlo) < 8u)
    asm volatile("" :: "v"(qr[0]), "v"(qr[1]), "v"(qr[2]), "v"(qr[3]));
    FL_WB_ALL();
    if constexpr (DV == 128 && !PIPE128) {
        f32x16 s0, s1;
        FL_DMAK(0, 0); FL_DMAV(0, 0);
        FL_DMAK(1, 1); FL_DMAV(1, 1);
        FL_WB_ONE();
        int st = 0;
        for (int t = 0; t < nt; ++t) {
            const int st2 = (st == 0) ? 2 : st - 1;
            FL_DMAK(t + 2, st2); FL_DMAV(t + 2, st2);
            qk_tile<false>(lds + st * KST + kro, qr, s0, s1);
            apply_bias<MODE>(s0, s1, t, hi, slope2, qpos, na_tab, na_d0, na_qc, na_cs);
            max_rescale<NDB>(s0, s1, o, mref, lacc, hi);
            softmax_pv<NDB>(lds + st * VBUF + vro, s0, s1, o, lacc);
            FL_WB_ONE();
            st = FL_NEXT(st);
        }
    } else {
        FL_DMAK(0, 0); FL_DMAV(0, 0); FL_DMAK(1, 1);
        FL_DMAK(2, 2); FL_DMAV(1, 1);
        FL_WB_ONE();
        f32x16 sa0, sa1, sb0, sb1;
        sa0 = zero16; sa1 = zero16; sb0 = zero16; sb1 = zero16;
        if (FL_ACT(0)) {
            qk_tile<false>(lds + kro, qr, sa0, sa1);
            apply_bias<MODE>(sa0, sa1, 0, hi, slope2, qpos, na_tab, na_d0, na_qc, na_cs);
            if constexpr (!NOMAX) max_rescale<NDB>(sa0, sa1, o, mref, lacc, hi);
        }
        f32x16 negm;
#pragma unroll
        for (int i = 0; i < 16; ++i) negm[i] = -mref;
        asm volatile("" : "+v"(negm));
        asm volatile("s_waitcnt lgkmcnt(0)\n\ts_barrier" ::: "memory");
        int sg = 0;
#define FL_BODY(C0, C1, N0, N1, T) do { \
        const int t_ = (T); const int sg1_ = FL_NEXT(sg), sg2_ = FL_NEXT(sg1_); \
        FL_DMAK(t_ + 3, sg); FL_DMAV(t_ + 2, sg2_); \
        const bool actc_ = FL_ACT(t_), actn_ = FL_ACT(t_ + 1); \
        if constexpr (MODE == 0 && DV == 64) { step_hs<NOMAX>(lds + sg1_ * KST + kro, lds + sg * VBUF + vro, qr, C0, C1, N0, N1, o, mref, lacc, hi, negm); } \
        else if constexpr (MODE == 1 && DV == 128) { step_hs128(lds + sg1_ * KST + kro, lds + sg * VBUF + vro, qr, C0, C1, N0, N1, o, mref, lacc, hi, slope2, qpos, t_ + 1, negm); } else { \
        if (actn_) qk_tile_c(lds + sg1_ * KST + kro, qr, N0, N1, negm); \
        if (actc_) softmax_pv<NDB>(lds + sg * VBUF + vro, C0, C1, o, lacc); \
        if (actn_) { apply_bias<MODE>(N0, N1, t_ + 1, hi, slope2, qpos, na_tab, na_d0, na_qc, na_cs); max_rescale_c<NDB>(N0, N1, o, mref, lacc, hi, negm); } } \
        FL_WB_ONE(); sg = sg1_; } while (0)
        int t = 0;
        for (; t + 2 < nt; t += 2) { FL_BODY(sa0, sa1, sb0, sb1, t); FL_BODY(sb0, sb1, sa0, sa1, t + 1); }
        if (t + 1 < nt) {
            FL_BODY(sa0, sa1, sb0, sb1, t);
            if (FL_ACT(t + 1)) softmax_pv<NDB>(lds + sg * VBUF + vro, sb0, sb1, o, lacc);
        } else {
            if (FL_ACT(t)) softmax_pv<NDB>(lds + sg * VBUF + vro, sa0, sa1, o, lacc);
        }
    }
    FL_WB_ALL();
#undef FL_DMAK
#undef FL_DMAV
#undef FL_WB_ALL
#undef FL_WB_ONE
#undef FL_NEXT
#undef FL_ACT
#undef FL_BODY
    ltot = lacc + __shfl_xor(lacc, 32);
}

__device__ __forceinline__ void gqa_unit(LAS unsigned char* lds, const bf16_t* Z, bf16_t* O, const float* qg, const float* kg, int b, int hq, int qb) {
    const int tid = otid(), lane = tid & 63, r32 = lane & 31, hi = lane >> 5, wid = tid >> 6;
    const int seq0 = seq0_of(b), L = seqlen_of(b);
    const size_t qrow = (size_t)seq0 + qb * 256 + wid * 32;
    const bf16_t* Qp = Z + (qrow + r32) * AB_IN + 1536 + hq * 64 + hi * 8;
    bf16x8 qr[4];
#pragma unroll
    for (int d0 = 0; d0 < 4; ++d0) qr[d0] = *(const bf16x8*)(Qp + d0 * 16);
    const int kvh = hq >> 2;
    f32x16 o[2]; float ltot;
    float gq = fabsf(qg[lane]), gk = fabsf(kg[lane]);
#pragma unroll
    for (int s_ = 1; s_ < 64; s_ <<= 1) { gq = fmaxf(gq, __shfl_xor(gq, s_)); gk = fmaxf(gk, __shfl_xor(gk, s_)); }
    const bool bounded = __builtin_amdgcn_readfirstlane(64.f * C2 * 1.05f * gq * gk <= 40.f ? 1 : 0) != 0;
    if (bounded) flash_core<64, 0, 1, 1>(lds, Z + (size_t)seq0 * AB_IN + 2048 + kvh * 64, AB_IN, Z + (size_t)seq0 * AB_IN + 2176 + kvh * 64, AB_IN, L / 64, qr, o, ltot, 0.f, 0, 0, 0, 0);
    else         flash_core<64, 0, 1, 0>(lds, Z + (size_t)seq0 * AB_IN + 2048 + kvh * 64, AB_IN, Z + (size_t)seq0 * AB_IN + 2176 + kvh * 64, AB_IN, L / 64, qr, o, ltot, 0.f, 0, 0, 0, 0);
    const float linv = 1.f / ltot;
    bf16_t* Op = O + qrow * DM + 512 + hq * 64 + r32;
#pragma unroll
    for (int r = 0; r < 16; ++r) {
        const int q = crow(r, hi); const float li = __shfl(linv, q);
#pragma unroll
        for (int d = 0; d < 2; ++d) Op[(size_t)q * DM + 32 * d] = f2bf(o[d][r] * li);
    }
}
__device__ __forceinline__ void na_unit(LAS unsigned char* lds, const bf16_t* Z, bf16_t* O, const float* rpb  , int b, int h, int R4) {
    const int tid = otid(), lane = tid & 63, r32 = lane & 31, hi = lane >> 5, wid = tid >> 6;
    const int seq0 = seq0_of(b), rows = seqlen_of(b) >> 6;
    const int r = 4 * R4 + (wid >> 1), half = wid & 1;
    const int kr0 = min(max(4 * R4 - 4, 0), rows - 8), kr1 = min(max(4 * R4 + 3 - 4, 0), rows - 8) + 8;
    const int rs = min(max(r - 4, 0), rows - 8);
    __syncthreads();
    {
        LAS float* tab = (LAS float*)(lds + ATT_TAB);
        for (int i = tid; i < 640; i += 512) { const int idx = i - 64; tab[i] = (idx >= 0 && idx < 465) ? rpb[h * 465 + idx] * LOG2E : 0.f; }
    }
    const size_t qrow = (size_t)seq0 + 64 * r + 32 * half;
    const bf16_t* Qp = Z + (qrow + r32) * AB_IN + h * 64 + hi * 8;
    bf16x8 qr[4];
#pragma unroll
    for (int d0 = 0; d0 < 4; ++d0) qr[d0] = *(const bf16x8*)(Qp + d0 * 16);
    f32x16 o[2]; float ltot;
    const size_t krow = (size_t)seq0 + 64 * kr0;
    flash_core<64, 2, 1>(lds, Z + krow * AB_IN + 512 + h * 64, AB_IN, Z + krow * AB_IN + 1024 + h * 64, AB_IN, kr1 - kr0, qr, o, ltot, 0.f, 0, rs - kr0, kr0 - r + 7, 32 * half + r32);
    const float linv = 1.f / ltot;
    bf16_t* Op = O + qrow * DM + h * 64 + r32;
#pragma unroll
    for (int rr = 0; rr < 16; ++rr) {
        const int q = crow(rr, hi); const float li = __shfl(linv, q);
#pragma unroll
        for (int d = 0; d < 2; ++d) Op[(size_t)q * DM + 32 * d] = f2bf(o[d][rr] * li);
    }
}
__device__ __forceinline__ void diff_epilogue(LAS unsigned char* lds, bf16_t* O, const float* lq1, const float* lk1, const float* lq2, const float* lk2, const float* subg, int li_,
                                              int row0, int h, f32x16 (&o)[4], float ltot) {
    const float lam_init = __uint_as_float(__builtin_amdgcn_readfirstlane(li_ == 1 ? 0x3eb60549u : 0x3f0e59d5u));
    const int tid = otid(), lane = tid & 63, r32 = lane & 31, hi = lane >> 5, wid = tid >> 6;
    const int mp = wid >> 2, wq = wid & 3;
    const float lam = __expf(wave_sum(lq1[lane] * lk1[lane])) - __expf(wave_sum(lq2[lane] * lk2[lane])) + lam_init;
    const float linv = 1.f / ltot;
    LAS float* ex = (LAS float*)lds + wq * 4096 + lane;
    if (mp == 1) {
#pragma unroll
        for (int r = 0; r < 16; ++r) {
            const float li = __shfl(linv, crow(r, hi)) * lam;
#pragma unroll
            for (int d = 0; d < 4; ++d) ex[(d * 16 + r) * 64] = o[d][r] * li;
        }
    }
    __syncthreads();
    if (mp == 0) {
        float gsc[4];
#pragma unroll
        for (int d = 0; d < 4; ++d) gsc[d] = subg[32 * d + r32] * (1.f - lam_init);
        bf16_t* Op = O + ((size_t)row0 + wq * 32) * DM + 512 + h * 128 + r32;
#pragma unroll
        for (int r = 0; r < 16; ++r) {
            const float li = __shfl(linv, crow(r, hi));
            float v[4];
#pragma unroll
            for (int d = 0; d < 4; ++d) v[d] = o[d][r] * li - ex[(d * 16 + r) * 64];
            float ss = (v[0] * v[0] + v[1] * v[1]) + (v[2] * v[2] + v[3] * v[3]);
            ss += __shfl_xor(ss, 1); ss += __shfl_xor(ss, 2); ss += __shfl_xor(ss, 4); ss += __shfl_xor(ss, 8); ss += __shfl_xor(ss, 16);
            const float rstd = __builtin_amdgcn_rsqf(ss * (1.f / 128.f) + 1e-6f);
            const int q = crow(r, hi);
#pragma unroll
            for (int d = 0; d < 4; ++d) Op[(size_t)q * DM + 32 * d] = f2bf(v[d] * rstd * gsc[d]);
        }
    }
    __syncthreads();
}
__device__ __forceinline__ void diff_unit(LAS unsigned char* lds, const bf16_t* Z, bf16_t* O, const float* lq1, const float* lk1, const float* lq2, const float* lk2,
                                          const float* subg, int li_, const unsigned* nrm  , int b, int h, int qb) {
    const int tid = otid(), lane = tid & 63, r32 = lane & 31, hi = lane >> 5, wid = tid >> 6;
    const int mp = wid >> 2, wq = wid & 3;
    const int seq0 = seq0_of(b), L = seqlen_of(b);
    const float slope2 = exp2f(-2.f * (float)(h + 1)) * LOG2E;
    const float sm0 = sqrtf(__uint_as_float(nrm[2 * h]) * __uint_as_float(nrm[8 + 2 * h])), sm1 = sqrtf(__uint_as_float(nrm[2 * h + 1]) * __uint_as_float(nrm[8 + 2 * h + 1]));
    const float smax2 = fmaxf(sm0, sm1) * 1.02f;
    const float Dk = (40.f + 2.f * smax2) / slope2;
    const int q0 = qb * 128, ntall = L / 64;
    const int t_lo = max(0, (int)ceilf(((float)q0 - Dk - 63.f) * (1.f / 64.f)));
    const int t_hi = min(ntall - 1, (int)floorf(((float)(q0 + 127) + Dk) * (1.f / 64.f)));
    const size_t qrow = (size_t)seq0 + q0 + wq * 32;
    const int qpos = q0 + wq * 32 + r32 - 64 * t_lo;
    const bf16_t* Qp = Z + (qrow + r32) * CD_IN + 1024 + h * 128 + mp * 64 + hi * 8;
    bf16x8 qr[4];
#pragma unroll
    for (int d0 = 0; d0 < 4; ++d0) qr[d0] = *(const bf16x8*)(Qp + d0 * 16);
    f32x16 o[4]; float ltot;
    const size_t krow = (size_t)seq0 + 64 * t_lo;
    flash_core<128, 1, 2>(lds, Z + krow * CD_IN + 1536 + h * 128, CD_IN, Z + krow * CD_IN + 2048 + h * 128, CD_IN, t_hi - t_lo + 1, qr, o, ltot, slope2, qpos, 0, 0, 0);
    diff_epilogue(lds, O, lq1, lk1, lq2, lk2, subg, li_, seq0 + q0, h, o, ltot);
}
__device__ __forceinline__ void conv_unit(LAS unsigned char* lds, const bf16_t* Z, bf16_t* O, const float* cw, const float* cb, const float* lg, const float* lb, int unit) {
    const int tid = otid(), lane = tid & 63, wid = tid >> 6;
    const int t0 = unit * 32, b = batch_of(t0), seq0 = seq0_of(b), send = seq0 + seqlen_of(b);
    const int c = tid;
    float w[31];
#pragma unroll
    for (int j = 0; j < 31; ++j) w[j] = cw[j * 512 + c];
    typedef float f32x2_t __attribute__((ext_vector_type(2)));
    f32x2_t wp[32];
#pragma unroll
    for (int m = 0; m < 32; ++m) wp[m] = (f32x2_t){m <= 30 ? w[m <= 30 ? m : 0] : 0.f, m >= 1 ? w[m >= 1 ? m - 1 : 0] : 0.f};
    f32x2_t acc2[16];
    const float bias = cb[c];
#pragma unroll
    for (int p = 0; p < 16; ++p) acc2[p] = (f32x2_t){bias, bias};
#pragma unroll
    for (int i = 0; i < 62; ++i) {
        const int tok = t0 - 15 + i;
        float uval = 0.f;
        if (tok >= seq0 && tok < send) {
            const float a = bf2f(Z[(size_t)tok * CD_IN + c]), g = bf2f(Z[(size_t)tok * CD_IN + 512 + c]);
            uval = a * __builtin_amdgcn_rcpf(1.f + fast_exp2(-g * LOG2E));
        }
        const f32x2_t uu = {uval, uval};
#pragma unroll
        for (int p = 0; p < 16; ++p) { if (i - 2 * p >= 0 && i - 2 * p <= 31) acc2[p] = __builtin_elementwise_fma(wp[i - 2 * p], uu, acc2[p]); }
    }
    float acc[32];
#pragma unroll
    for (int p = 0; p < 16; ++p) { acc[2 * p] = acc2[p][0]; acc[2 * p + 1] = acc2[p][1]; }
    LAS float* sm = (LAS float*)lds;
    __syncthreads();
#pragma unroll
    for (int t = 0; t < 32; ++t) sm[t * 512 + c] = acc[t];
    __syncthreads();
#pragma unroll
    for (int tt = 0; tt < 4; ++tt) {
        const int t = wid * 4 + tt;
        float v[8]; float s = 0.f;
#pragma unroll
        for (int k = 0; k < 8; ++k) { v[k] = sm[t * 512 + lane + 64 * k]; s += v[k]; }
        const float mean = wave_sum(s) * (1.f / 512.f);
        float q = 0.f;
#pragma unroll
        for (int k = 0; k < 8; ++k) { v[k] -= mean; q += v[k] * v[k]; }
        const float rstd = __builtin_amdgcn_rsqf(wave_sum(q) * (1.f / 512.f) + 1e-5f);
#pragma unroll
        for (int k = 0; k < 8; ++k) {
            const int cc = lane + 64 * k;
            const float y = v[k] * rstd * lg[cc] + lb[cc];
            O[(size_t)(t0 + t) * DM + cc] = f2bf(silu_f(y));
        }
    }
    __syncthreads();
}

__constant__ float ROPE_INV[16] = {1.f, 0.562341332f, 0.316227764f, 0.177827939f, 0.100000001f, 0.0562341325f, 0.0316227749f, 0.0177827943f,
                                   0.00999999978f, 0.00562341325f, 0.00316227763f, 0.00177827943f, 0.00100000005f, 0.000562341302f, 0.000316227757f, 0.00017782794f};

__device__ __forceinline__ void transpose_item(const float* __restrict__ W, int K, int N, bf16_t* __restrict__ WT, int k0, int n0, int drow0, LAS float* scr, int lane) {
    float wv[32];
    const float* wp = W + (size_t)(k0 + (lane >> 5)) * N + n0 + (lane & 31);
#pragma unroll
    for (int i = 0; i < 32; ++i) wv[i] = wp[(size_t)(2 * i) * N];
#pragma unroll
    for (int i = 0; i < 32; ++i) scr[(2 * i + (lane >> 5)) * 33 + (lane & 31)] = wv[i];
    asm volatile("s_waitcnt lgkmcnt(0)" ::: "memory");
    const int c = lane & 7;
#pragma unroll
    for (int j = 0; j < 4; ++j) {
        const int n = (lane >> 3) + 8 * j; const LAS float* s = scr + (8 * c) * 33 + n;
        u32x4 o; o.x = pk_bf16(s[0 * 33], s[1 * 33]); o.y = pk_bf16(s[2 * 33], s[3 * 33]); o.z = pk_bf16(s[4 * 33], s[5 * 33]); o.w = pk_bf16(s[6 * 33], s[7 * 33]);
        *(u32x4*)(WT + (size_t)(drow0 + n) * K + k0 + 8 * c) = o;
    }
    asm volatile("s_waitcnt lgkmcnt(0)" ::: "memory");
}

__device__ __forceinline__ void prologue(const Args& a, LAS unsigned char* lds) {
    const int tid = otid(), lane = tid & 63, wid = tid >> 6;
    const int gw = blockIdx.x * 8 + wid, NGW = gridDim.x * 8;
    unsigned char* ws = a.ws;
    LAS float* scr = (LAS float*)(lds + wid * 8448);
    constexpr int I_INAB = 16 * 72, I_OUT = 16 * 32, I_INCD = 16 * 80, I_W1 = 16 * 88, I_W2 = 44 * 32;
    constexpr int NITEMS = 2 * (I_INAB + I_OUT + I_INCD + I_OUT) + 8 * I_W1 + 4 * I_W2;
    for (int it = gw; it < NITEMS; it += NGW) {
        int r = it; const float* src; bf16_t* dst; int K = DM, N, nblk, mode, q;
        if (r < 2 * I_INAB) { const int m = r / I_INAB; q = r % I_INAB; N = AB_IN; src = a.in[8] + (size_t)m * DM * AB_IN; dst = (bf16_t*)(ws + WS_WINAB + m * SZ_WINAB); mode = 1; }
        else if ((r -= 2 * I_INAB) < 2 * I_OUT) { const int m = r / I_OUT; q = r % I_OUT; N = DM; src = a.in[12] + (size_t)m * DM * DM; dst = (bf16_t*)(ws + WS_WOUTAB + m * SZ_WOUT); mode = 0; }
        else if ((r -= 2 * I_OUT) < 2 * I_INCD) { const int m = r / I_INCD; q = r % I_INCD; N = CD_IN; src = a.in[13] + (size_t)m * DM * CD_IN; dst = (bf16_t*)(ws + WS_WINCD + m * SZ_WINCD); mode = 1; }
        else if ((r -= 2 * I_INCD) < 2 * I_OUT) { const int m = r / I_OUT; q = r % I_OUT; N = DM; src = a.in[23] + (size_t)m * DM * DM; dst = (bf16_t*)(ws + WS_WOUTCD + m * SZ_WOUT); mode = 0; }
        else if ((r -= 2 * I_OUT) < 4 * I_W1) { const int m = r / I_W1; q = r % I_W1; N = DFF; src = a.in[24] + (size_t)m * DM * DFF; dst = (bf16_t*)(ws + WS_W13 + m * SZ_W13); mode = 2; }
        else if ((r -= 4 * I_W1) < 4 * I_W1) { const int m = r / I_W1; q = r % I_W1; N = DFF; src = a.in[25] + (size_t)m * DM * DFF; dst = (bf16_t*)(ws + WS_W13 + m * SZ_W13); mode = 3; }
        else { r -= 4 * I_W1; const int m = r / I_W2; q = r % I_W2; K = DFF; N = DM; src = a.in[26] + (size_t)m * DFF * DM; dst = (bf16_t*)(ws + WS_W2 + m * SZ_W2); mode = 0; }
        nblk = N / 32;
        const int kb = q / nblk, nb = q % nblk;
        int drow;
        if (mode == 1) { const int pn = nb >> 3, lg = nb & 7; drow = 256 * pn + 32 * (4 * (lg & 1) + (lg >> 1)); }
        else if (mode == 2) drow = 256 * (nb >> 2) + 32 * (nb & 3);
        else if (mode == 3) drow = 256 * (nb >> 2) + 128 + 32 * (nb & 3);
        else drow = 32 * nb;
        transpose_item(src, K, N, dst, 64 * kb, 32 * nb, drow, scr, lane);
    }
    {
        const int g = blockIdx.x * 512 + tid;
        if (g < 64) ((unsigned*)ws)[g] = 0u;
        if (g < 4096) {
            const int pos = g >> 4, i = g & 15;
            const float ang = (float)pos * ROPE_INV[i];
            const double x = (double)ang;
            const double n = rint(x * 0.15915494309189535);
            const float rr = (float)(x - n * 6.283185307179586);
            float* rp = (float*)(ws + WS_ROPE) + g * 2;
            rp[0] = __cosf(rr); rp[1] = __sinf(rr);
        }
    }
    __syncthreads();
    {
        LAS float* cs = (LAS float*)lds;
        LAS float* part = (LAS float*)(lds + 36864);
        bool filled = false;
        for (int u = blockIdx.x; u < 384; u += gridDim.x) {
            if (!filled) {
                for (int i = tid; i < NBATCH * DM; i += 512) { const float v = i < 8 * DM ? a.in[2][i] : a.in[3][i - 8 * DM]; cs[i] = silu_f(v); }
                filled = true;
            }
            __syncthreads();
            const int li = u / 96, n0 = (u % 96) * 64;
            const float* wp = a.in[4] + (size_t)li * DM * 6144 + (size_t)(wid * 128) * 6144 + n0 + lane;
            float acc[NBATCH];
#pragma unroll
            for (int bb = 0; bb < NBATCH; ++bb) acc[bb] = 0.f;
#pragma unroll 8
            for (int k = 0; k < 128; ++k) {
                const float wv = wp[(size_t)k * 6144];
#pragma unroll
                for (int bb = 0; bb < NBATCH; ++bb) acc[bb] = fmaf(cs[bb * DM + wid * 128 + k], wv, acc[bb]);
            }
#pragma unroll
            for (int bb = 0; bb < NBATCH; ++bb) part[(wid * NBATCH + bb) * 64 + lane] = acc[bb];
            __syncthreads();
            for (int i = tid; i < NBATCH * 64; i += 512) {
                const int bb = i >> 6, l = i & 63;
                float s = a.in[5][li * 6144 + n0 + l];
#pragma unroll
                for (int w8 = 0; w8 < 8; ++w8) s += part[(w8 * NBATCH + bb) * 64 + l];
                ((float*)(ws + WS_MOD))[((size_t)li * NBATCH + bb) * 6144 + n0 + l] = s;
            }
        }
    }
}

template <bool F32IN>
__device__ __forceinline__ void norm_phase(const float* xp, const float* xs, const bf16_t* xb, bf16_t* H, const float* g, const float* modl  , int shift_chunk) {
    const int tid = otid(), lane = tid & 63, wid = tid >> 6;
    const int gw = blockIdx.x * 8 + wid, NGW = gridDim.x * 8;
    for (int ch = gw; ch < T_ALL / 8; ch += NGW) {
        const int row0 = ch * 8, b = batch_of(row0);
        const float* sh = modl + b * 6144 + shift_chunk * DM; const float* sc = sh + DM;
        f32x4 mul[4], add[4];
#pragma unroll
        for (int j = 0; j < 4; ++j) {
            const int c = 4 * lane + 256 * j;
            mul[j] = *(const f32x4*)(g + c) * (*(const f32x4*)(sc + c) + 1.f); add[j] = *(const f32x4*)(sh + c);
        }
        const float* xr0 = row0 < T_PROMPT ? xp + (size_t)row0 * DM : xs + (size_t)(row0 - T_PROMPT) * DM;
#pragma unroll 1
        for (int r4 = 0; r4 < 8; r4 += 4) {
            f32x4 v[4][4];
#pragma unroll
            for (int rr = 0; rr < 4; ++rr)
#pragma unroll
                for (int j = 0; j < 4; ++j) {
                    if constexpr (F32IN) v[rr][j] = *(const f32x4*)(xr0 + (size_t)(r4 + rr) * DM + 4 * lane + 256 * j);
                    else { const u32x2 w = *(const u32x2*)(xb + (size_t)(row0 + r4 + rr) * DM + 4 * lane + 256 * j);
                           v[rr][j] = (f32x4){__uint_as_float(w.x << 16), __uint_as_float(w.x & 0xffff0000u), __uint_as_float(w.y << 16), __uint_as_float(w.y & 0xffff0000u)}; }
                }
#pragma unroll
            for (int rr = 0; rr < 4; ++rr) {
                float s = 0.f;
#pragma unroll
                for (int j = 0; j < 4; ++j) s += (v[rr][j][0] * v[rr][j][0] + v[rr][j][1] * v[rr][j][1]) + (v[rr][j][2] * v[rr][j][2] + v[rr][j][3] * v[rr][j][3]);
                const float rstd = __builtin_amdgcn_rsqf(wave_sum(s) * (1.f / DM) + 1e-6f);
#pragma unroll
                for (int j = 0; j < 4; ++j) {
                    const f32x4 y = v[rr][j] * rstd * mul[j] + add[j];
                    u32x2 w; w.x = pk_bf16(y[0], y[1]); w.y = pk_bf16(y[2], y[3]);
                    *(u32x2*)(H + (size_t)(row0 + r4 + rr) * DM + 4 * lane + 256 * j) = w;
                }
            }
        }
    }
}
__device__ __forceinline__ void final_norm_pass1(const bf16_t* xb, bf16_t* H, float* out, const float* g, int rowlim) {
    const int tid = otid(), lane = tid & 63, wid = tid >> 6;
    const int gw = blockIdx.x * 8 + wid, NGW = gridDim.x * 8;
    f32x4 mul[4];
#pragma unroll
    for (int j = 0; j < 4; ++j) mul[j] = *(const f32x4*)(g + 4 * lane + 256 * j);
    for (int row0 = gw * 4; row0 < T_ALL; row0 += NGW * 4) {
        f32x4 v[4][4];
#pragma unroll
        for (int rr = 0; rr < 4; ++rr)
#pragma unroll
            for (int j = 0; j < 4; ++j) { const u32x2 w = *(const u32x2*)(xb + (size_t)(row0 + rr) * DM + 4 * lane + 256 * j);
                v[rr][j] = (f32x4){__uint_as_float(w.x << 16), __uint_as_float(w.x & 0xffff0000u), __uint_as_float(w.y << 16), __uint_as_float(w.y & 0xffff0000u)}; }
#pragma unroll
        for (int rr = 0; rr < 4; ++rr) {
            float s = 0.f;
#pragma unroll
            for (int j = 0; j < 4; ++j) s += (v[rr][j][0] * v[rr][j][0] + v[rr][j][1] * v[rr][j][1]) + (v[rr][j][2] * v[rr][j][2] + v[rr][j][3] * v[rr][j][3]);
            const float rstd = __builtin_amdgcn_rsqf(wave_sum(s) * (1.f / DM) + 1e-6f);
            if (row0 < rowlim) {
#pragma unroll
                for (int j = 0; j < 4; ++j) *(f32x4*)(out + (size_t)(row0 + rr) * DM + 4 * lane + 256 * j) = v[rr][j] * rstd * mul[j];
            } else {
#pragma unroll
                for (int j = 0; j < 4; ++j) { const f32x4 y = v[rr][j] * rstd * mul[j]; u32x2 w; w.x = pk_bf16(y[0], y[1]); w.y = pk_bf16(y[2], y[3]);
                    *(u32x2*)(H + (size_t)(row0 + rr) * DM + 4 * lane + 256 * j) = w; }
            }
        }
    }
}
__device__ __forceinline__ void final_norm_pass2(const bf16_t* H, float* out, int k2) {
    const int tid = otid();
    const size_t gt = (size_t)blockIdx.x * 512 + tid, GT = (size_t)gridDim.x * 512;
    for (size_t i = (size_t)T_ALL * DM / 16 * (size_t)k2 + gt; i < (size_t)T_ALL * DM / 8; i += GT) {
        const u32x4 w = *(const u32x4*)(H + i * 8);
        const f32x4 a = {__uint_as_float(w.x << 16), __uint_as_float(w.x & 0xffff0000u), __uint_as_float(w.y << 16), __uint_as_float(w.y & 0xffff0000u)};
        const f32x4 b = {__uint_as_float(w.z << 16), __uint_as_float(w.z & 0xffff0000u), __uint_as_float(w.w << 16), __uint_as_float(w.w & 0xffff0000u)};
        *(f32x4*)(out + i * 8) = a; *(f32x4*)(out + i * 8 + 4) = b;
    }
}

#define XB_TMO      128
#define XB_XCNT(j)  (256  + 64 * (j))
#define XB_XSUB(j)  (1280 + 64 * (j))
#define XB_XGEN(j)  (2304 + 64 * (j))
#define XB_TOP      3328
#define XB_TOPGEN   3392
#define XCD_BAR_WORDS 3456
#define XB_SPIN_CAP (1u << 18)

__device__ __forceinline__ unsigned xb_ld(unsigned* p)              { return __hip_atomic_load(p, __ATOMIC_RELAXED, __HIP_MEMORY_SCOPE_AGENT); }
__device__ __forceinline__ unsigned xb_add(unsigned* p, unsigned v) { return __hip_atomic_fetch_add(p, v, __ATOMIC_RELAXED, __HIP_MEMORY_SCOPE_AGENT); }
__device__ __forceinline__ unsigned xb_xcc_id() { return (unsigned)__builtin_amdgcn_s_getreg((3 << 11) | 20) & 0xFu; }
#define XB_SPIN(cond, bar) do { unsigned _sp = 0; while (cond) { __builtin_amdgcn_s_sleep(1); \
    if ((++_sp & 255u) == 0u) { if (xb_ld(&(bar)[XB_TMO])) break; if (_sp > XB_SPIN_CAP) { atomicAdd(&(bar)[XB_TMO], 1u); break; } } } } while (0)

struct XcdBarrier {
    unsigned* bar; unsigned x;
    volatile LAS unsigned* st;
};

__device__ __forceinline__ XcdBarrier xcd_barrier_post(unsigned* bar, volatile LAS unsigned* st) {
    XcdBarrier b; b.bar = bar; b.x = xb_xcc_id(); b.st = st;
    if (threadIdx.x == 0) (void)xb_add(&bar[XB_XCNT(b.x)], 1u);
    return b;
}
__device__ __forceinline__ void xcd_barrier_complete(unsigned* bar, unsigned x, unsigned& nloc, unsigned& nx) {
    const unsigned G = gridDim.x * gridDim.y * gridDim.z;
    unsigned sum, cnt, mine, sp = 0u;
    for (;;) {
        sum = 0u; cnt = 0u; mine = 0u;
#pragma unroll
        for (unsigned j = 0; j < 16; ++j) { const unsigned c = xb_ld(&bar[XB_XCNT(j)]); sum += c; cnt += (c > 0u) ? 1u : 0u; mine = (j == x) ? c : mine; }
        if (sum == G) break;
        __builtin_amdgcn_s_sleep(1);
        if ((++sp & 255u) == 0u) { if (xb_ld(&bar[XB_TMO])) break; if (sp > XB_SPIN_CAP) { atomicAdd(&bar[XB_TMO], 1u); break; } }
    }
    nloc = mine > 0u ? mine : 1u; nx = cnt > 0u ? cnt : 1u;
}

__device__ __forceinline__ void xcd_barrier(const XcdBarrier& b) {
    asm volatile("s_waitcnt vmcnt(0)" ::: "memory");
    __syncthreads();
    if (threadIdx.x == 0) {
        unsigned* bar = b.bar;
        __builtin_amdgcn_s_waitcnt(0);
        unsigned nloc = b.st[0], nx = b.st[1];
        if (nloc == 0u) { xcd_barrier_complete(bar, b.x, nloc, nx); b.st[0] = nloc; b.st[1] = nx; }
        const unsigned old = xb_add(&bar[XB_XSUB(b.x)], 1u);
        const unsigned gen = old / nloc;
        if (old + 1u == (gen + 1u) * nloc) {
            __builtin_amdgcn_fence(__ATOMIC_RELEASE, "agent");
            asm volatile("s_waitcnt vmcnt(0)" ::: "memory");
            const unsigned og = xb_add(&bar[XB_TOP], 1u);
            const unsigned tg = og / nx;
            if (og + 1u == (tg + 1u) * nx) xb_add(&bar[XB_TOPGEN], 1u);
            else XB_SPIN(xb_ld(&bar[XB_TOPGEN]) == tg, bar);
            __builtin_amdgcn_fence(__ATOMIC_ACQUIRE, "agent");
            xb_add(&bar[XB_XGEN(b.x)], 1u);
            asm volatile("s_waitcnt vmcnt(0)" ::: "memory");
        } else {
            XB_SPIN(xb_ld(&bar[XB_XGEN(b.x)]) == gen, bar);
            __builtin_amdgcn_fence(__ATOMIC_ACQUIRE, "agent");
            asm volatile("s_waitcnt vmcnt(0)" ::: "memory");
        }
    }
    __syncthreads();
}

#ifndef PROBE_PH
#define PROBE_PH -1
#define PROBE_PH2 -1
#endif
#ifndef PROBE_REP
#define PROBE_REP 0
#define PROBE_LI 0
#endif
#ifndef ONLY
#define ONLY 0
#endif
#define EN(k) (ONLY == 0 || ONLY == (k))
__global__ void __launch_bounds__(512) mega_fwd(Args a) {
    extern __shared__ __attribute__((aligned(16))) unsigned char lds_raw[];
    LAS unsigned char* lds = (LAS unsigned char*)lds_raw;
    cg::grid_group grid = cg::this_grid();
    unsigned char* ws = a.ws;
    float* mod = (float*)(ws + WS_MOD);
    bf16_t* H = (bf16_t*)(ws + WS_H);
    bf16_t* Zb = (bf16_t*)(ws + WS_Z);
    float* xout = a.out;
    bf16_t* xb = (bf16_t*)(a.out + (size_t)T_ALL * DM / 2);
    volatile LAS unsigned* bst = (volatile LAS unsigned*)(lds + 131072 + 64);
    if (otid() < 2) bst[otid()] = 0u;
    __syncthreads();
    XcdBarrier xbar = xcd_barrier_post((unsigned*)(ws + WS_BAR), bst);
#ifdef PROBE_NSYNC
    for (int i_ = 0; i_ < PROBE_NSYNC; ++i_) xcd_barrier(xbar);
#endif
    if (EN(1)) prologue(a, lds);
    grid.sync();
    for (int ph_ = 1; ph_ < a.ph_hi; ++ph_) {
        if (ph_ > 1) xcd_barrier(xbar);
#if PROBE_PH >= 0
        const int ph = ph_ - (ph_ > PROBE_PH ? 1 : 0) - ((PROBE_PH2 >= 0 && ph_ > PROBE_PH2 + 1) ? 1 : 0);
#else
        const int ph = ph_;
#endif
        {
        if (ph == 0) { if (EN(1)) prologue(a, lds); }
        else
        if (ph == NPHASE - 2) { if (EN(2)) final_norm_pass1(H, H, xout, a.in[27], (a.ph_hi - NPHASE + 1) * T_ALL); }
        else if (ph == NPHASE - 1) { if (EN(2)) final_norm_pass2(H, xout, a.ph_hi - NPHASE + 2); }
        else {
        const int li = (ph - 1) / 7, sub = (ph - 1) % 7, j = li >> 1;
        const bool cd = (li & 1) != 0;
        const float* modl = mod + (size_t)li * NBATCH * 6144;
        if (sub == 0 || sub == 4) {
            if (li == 0 && sub == 0) { if (EN(2)) norm_phase<true>(a.in[0], a.in[1], xb, H, a.in[6] + li * DM, modl, 0); }
            else { if (EN(2)) norm_phase<false>(nullptr, nullptr, xb, H, (sub == 0 ? a.in[6] : a.in[7]) + li * DM, modl, sub == 0 ? 0 : 3); }
        } else if (sub == 1) {
            pg8::StaticOrder S;
            if (!cd) {
                pg8::Gemm g{H, (const bf16_t*)(ws + WS_WINAB + j * SZ_WINAB), T_ALL, AB_IN, DM}; S.init(T_ALL, AB_IN, gridDim.x, blockIdx.x);
                EpiInAB E{Zb, a.in[10] + j * 64, a.in[11] + j * 64, (const float*)(ws + WS_ROPE)};
                if (EN(3)) pg8::gemm_phase<EpiInAB, pg8::StaticOrder, true, true>(lds, g, S, E);
            } else {
                pg8::Gemm g{H, (const bf16_t*)(ws + WS_WINCD + j * SZ_WINCD), T_ALL, CD_IN, DM}; S.init(T_ALL, CD_IN, gridDim.x, blockIdx.x);
                EpiInCD E{Zb, (unsigned*)ws + 16 * j};
                if (EN(4)) pg8::gemm_phase<EpiInCD, pg8::StaticOrder, true, true>(lds, g, S, E);
            }
        } else if (sub == 2) {
#if PROBE_REP
          for (int rep_ = 0; rep_ < ((li == PROBE_LI) ? 2 : 1); ++rep_) {
            if (rep_) grid.sync();
#else
          {
#endif
            if (!cd) {
                const float* rpb = a.in[9] + (size_t)j * 8 * 465;
                if (EN(5)) for (int u = blockIdx.x; u < 3072; u += gridDim.x) {
                    if (u < 512) gqa_unit(lds, Zb, H, a.in[10] + j * 64, a.in[11] + j * 64, 8, u >> 6, u & 63);
                    else if (u < 1536) { const int v = u - 512; gqa_unit(lds, Zb, H, a.in[10] + j * 64, a.in[11] + j * 64, v >> 7, (v >> 4) & 7, v & 15); }
                    else if (u < 2048) { const int v = u - 1536; na_unit(lds, Zb, H, rpb, 8, v >> 6, v & 63);
#ifdef PROBE_NA2
                        if (li == 0) na_unit(lds, Zb, H, rpb, 8, v >> 6, v & 63);
#endif
                    }
                    else { const int v = u - 2048; na_unit(lds, Zb, H, rpb, v >> 7, (v >> 4) & 7, v & 15);
#ifdef PROBE_NA2
                        if (li == 0) na_unit(lds, Zb, H, rpb, v >> 7, (v >> 4) & 7, v & 15);
#endif
                    }
                }
            } else {
                const unsigned* nrm = (const unsigned*)ws + 16 * j;
                int* ctr = (int*)ws + 32 + ph_;
                LAS int* uw = (LAS int*)(lds + 131072);
                if (EN(6) || ONLY == 9) for (;;) {
                    __syncthreads();
                    if (otid() == 0) *uw = atomicAdd(ctr, 1);
                    __syncthreads();
                    const int u = __builtin_amdgcn_readfirstlane(*uw);
                    if (u >= 3072) break;
                    if (u < 1536) {
                        int b, h, qb;
                        if (u < 128) { b = 8; h = 3; qb = u; }
                        else if (u < 256) { b = 8; h = 2; qb = u - 128; }
                        else if (u < 768) { const int v = u - 256; h = 3 - (v >> 8); b = (v >> 5) & 7; qb = v & 31; }
                        else if (u < 896) { b = 8; h = 1; qb = u - 768; }
                        else if (u < 1152) { const int v = u - 896; h = 1; b = v >> 5; qb = v & 31; }
                        else if (u < 1280) { b = 8; h = 0; qb = u - 1152; }
                        else { const int v = u - 1280; h = 0; b = v >> 5; qb = v & 31; }
                        if (ONLY != 9) diff_unit(lds, Zb, H, a.in[18] + j * 64, a.in[19] + j * 64, a.in[20] + j * 64, a.in[21] + j * 64, a.in[22] + j * 128, li, nrm, b, h, qb);
                    } else if (ONLY != 6) conv_unit(lds, Zb, H, a.in[14] + (size_t)j * 31 * 512, a.in[15] + j * 512, a.in[16] + j * 512, a.in[17] + j * 512, u - 1536);
                }
            }
          }
        } else if (sub == 3 || sub == 6) {
            pg8::StaticOrder S; S.init(T_ALL, DM, gridDim.x, blockIdx.x);
            pg8::Gemm g;
            if (sub == 3) g = pg8::Gemm{H, (const bf16_t*)(ws + (cd ? WS_WOUTCD : WS_WOUTAB) + j * SZ_WOUT), T_ALL, DM, DM};
            else g = pg8::Gemm{Zb, (const bf16_t*)(ws + WS_W2 + li * SZ_W2), T_ALL, DM, DFF};
            const bool first = (li == 0 && sub == 3);
            if (first) {
                EpiRes<true> E{a.in[0], a.in[1], xb, modl + (sub == 3 ? 2 : 5) * DM, (PROBE_PH >= 0 && ph_ == PROBE_PH + 1) ? Zb : xb};
                if (EN(7)) pg8::gemm_phase<EpiRes<true>, pg8::StaticOrder, true, true>(lds, g, S, E);
            } else {
                EpiRes<false> E{nullptr, nullptr, xb, modl + (sub == 3 ? 2 : 5) * DM, (sub == 6 && li == 3) ? H : xb};
                if (EN(7)) pg8::gemm_phase<EpiRes<false>, pg8::StaticOrder, true, true>(lds, g, S, E);
            }
        } else {
            pg8::StaticOrder S; S.init(T_ALL, 2 * DFF, gridDim.x, blockIdx.x);
            pg8::Gemm g{H, (const bf16_t*)(ws + WS_W13 + li * SZ_W13), T_ALL, 2 * DFF, DM};
            EpiUp E{Zb};
            if (EN(8)) pg8::gemm_phase<EpiUp, pg8::StaticOrder, true, true>(lds, g, S, E);
        }
        }
        }
    }
}

#ifndef MK_SINGLE
#define MK_SINGLE 1
#endif
extern "C" void kernel_launch(void* const* d_in, const int* in_sizes, int n_in, void* d_out, int out_size, void* d_ws, size_t ws_size, hipStream_t stream) {
    static int grid = 0;
    if (grid == 0) {
        if (n_in != 28 || out_size != T_ALL * DM || ws_size < WS_NEED) { fprintf(stderr, "kernel_launch: unexpected shapes (n_in %d out %d ws %zu)\n", n_in, out_size, ws_size); grid = -1; return; }
        int dev = 0, cus = 0, per_cu = 0;
        hipGetDevice(&dev); hipDeviceGetAttribute(&cus, hipDeviceAttributeMultiprocessorCount, dev);
        hipFuncSetAttribute((const void*)mega_fwd, hipFuncAttributeMaxDynamicSharedMemorySize, LDS_BYTES);
        hipOccupancyMaxActiveBlocksPerMultiprocessor(&per_cu, (const void*)mega_fwd, 512, LDS_BYTES);
        if (per_cu < 1) { fprintf(stderr, "kernel_launch: occupancy query says %d blocks per CU\n", per_cu); per_cu = 1; }
        (void)hipGetLastError();
        grid = cus * 1;
    }
    if (grid < 0) return;
    Args a{};
    for (int i = 0; i < 28; ++i) a.in[i] = (const float*)d_in[i];
    a.out = (float*)d_out; a.ws = (unsigned char*)d_ws;
    (void)hipMemsetAsync((char*)d_ws + WS_BAR, 0, 16384, stream);
#if MK_SINGLE
    a.ph_lo = 0; a.ph_hi = NPHASE + (PROBE_PH >= 0 ? 1 : 0) + (PROBE_PH2 >= 0 ? 1 : 0);
    void* args[] = {&a};
    hipError_t e = hipLaunchCooperativeKernel((const void*)mega_fwd, dim3(grid), dim3(512), args, LDS_BYTES, stream);
    if (e != hipSuccess) fprintf(stderr, "cooperative launch failed: %s (grid %d)\n", hipGetErrorString(e), grid);
#else
    for (int ph = 0; ph < NPHASE; ++ph) {
        a.ph_lo = ph; a.ph_hi = ph + 1;
        hipLaunchKernelGGL(mega_fwd, dim3(grid), dim3(512), LDS_BYTES, stream, a);
    }
#endif
}
```

```cpp
#include <hip/hip_runtime.h>
#include <hip/hip_cooperative_groups.h>
#include <cstdio>
#include <cstdint>
namespace cg = cooperative_groups;
namespace pg8 {
#define PG8_LAS __attribute__((address_space(3)))
typedef unsigned short bf16_t;
typedef short bf16x8 __attribute__((ext_vector_type(8)));
typedef float f32x4 __attribute__((ext_vector_type(4)));
typedef unsigned u32x4 __attribute__((ext_vector_type(4)));
constexpr int BM = 256, BK = 64, HALF = 128, HTB = HALF * BK * 2  , STAGE_BYTES = 8 * HTB, NXCD = 8, WGM = 8;

__host__ __device__ __forceinline__ int lds_byte(int r, int c) { const int st = (r >> 4) * 2 + (c >> 5), rr = r & 15, cc = c & 31, ob = rr * 64 + cc * 2; return st * 1024 + (ob ^ (((ob >> 9) & 1) << 5)); }
__host__ __device__ __forceinline__ void stage_rc(int b, int& R, int& C) { const int st = b / 1024, sb = b % 1024, swz = sb ^ (((sb >> 9) & 1) << 5); R = (st >> 1) * 16 + swz / 64; C = (st & 1) * 32 + (swz % 64) / 2; }
__host__ __device__ __forceinline__ int perm32(int rho) { const int n = rho >> 4, i = rho & 15; return 8 * (i >> 2) + 4 * n + (i & 3); }

struct Unit { int pm, pn; };
struct Gemm { const bf16_t* A; const bf16_t* Bt; int M, N, K; };

struct StaticOrder {
    int nM, nN, nwg, G, c;
    __host__ __device__ void init(int M, int N, int G_, int c_) { nM = M / BM; nN = N / BM; nwg = nM * nN; G = G_; c = c_; }
    __host__ __device__ bool next(int i, Unit& u) const {
        const long L = (long)i * G + c; if (L >= nwg) return false;
        int wgid = (int)L; { const int q = nwg / NXCD, r = nwg % NXCD, xcd = wgid % NXCD, off = wgid / NXCD; wgid = (xcd < r ? xcd * (q + 1) : r * (q + 1) + (xcd - r) * q) + off; }
        const int nig = WGM * nN, gid = wgid / nig, fm = gid * WGM, gsz = (nM - fm) < WGM ? (nM - fm) : WGM;
        u.pm = fm + ((wgid % nig) % gsz); u.pn = (wgid % nig) / gsz; return true;
    }
    __device__ __forceinline__ void a_ready(const Unit&) const {}
    __device__ __forceinline__ void done(const Unit&) const {}
};

__device__ __forceinline__ unsigned cvt_pk_bf16(float lo, float hi) { unsigned r; asm volatile("v_cvt_pk_bf16_f32 %0, %1, %2" : "=v"(r) : "v"(lo), "v"(hi)); return r; }
typedef float f32x2 __attribute__((ext_vector_type(2)));
template <class Epi, class Sched, bool ALIGN_EPI = false, bool SP2 = false>
__device__ __forceinline__ void gemm_phase(PG8_LAS unsigned char* lds, const Gemm g, const Sched& S, const Epi& E) {
    int tid_ = threadIdx.x; asm volatile("" : "+v"(tid_)); const int tid = tid_, wid = __builtin_amdgcn_readfirstlane(tid >> 6), lane = tid & 63, wr = wid >> 2, wc = wid & 3, fr = lane & 15, fq = lane >> 4;
    const int K = g.K, nt = K / BK;
    unsigned voffA[2], voffB[2];
#pragma unroll
    for (int i = 0; i < 2; ++i) { int R, C; stage_rc(tid * 16 + i * 8192, R, C); const int Rb = Epi::PERM ? ((R & ~31) + perm32(R & 31)) : R;
        voffA[i] = (unsigned)(R * K + C) * 2u; voffB[i] = (unsigned)(Rb * K + C) * 2u; }
    const size_t kstep = (size_t)(BK * 2);
    const size_t hstep = (size_t)HALF * K * 2;
    const size_t tstep = 2 * hstep;
    const unsigned ldsw = (unsigned)wid * 1024u;
    const int aoff = lds_byte(wr * 64 + fr, fq * 8), boff = lds_byte(wc * 32 + fr, fq * 8);
#define PG8_SA(b, h) (((b) * 2 + (h)) * HTB)
#define PG8_SB(b, h) ((4 + (b) * 2 + (h)) * HTB)
#define PG8_STAGE(bufoff, gbase, voff) do { _Pragma("unroll") for (int _i = 0; _i < 2; ++_i) \
        __builtin_amdgcn_global_load_lds((const unsigned*)((const char*)(gbase) + (voff)[_i]), (PG8_LAS unsigned*)(lds + (bufoff) + ldsw + _i * 8192), 16, 0, 0); } while (0)
#define PG8_LDA(dst, b, h) do { _Pragma("unroll") for (int m = 0; m < 4; ++m) _Pragma("unroll") for (int k = 0; k < 2; ++k) dst[m][k] = *(const PG8_LAS bf16x8*)(lds + PG8_SA(b, h) + aoff + m * 2048 + k * 1024); } while (0)
#define PG8_LDB(dst, b, h) do { _Pragma("unroll") for (int n = 0; n < 2; ++n) _Pragma("unroll") for (int k = 0; k < 2; ++k) dst[n][k] = *(const PG8_LAS bf16x8*)(lds + PG8_SB(b, h) + boff + n * 2048 + k * 1024); } while (0)
#define PG8_MMA(ai, bj, At, Bt) do { __builtin_amdgcn_s_setprio(1); _Pragma("unroll") for (int m = 0; m < 4; ++m) _Pragma("unroll") for (int n = 0; n < 2; ++n) _Pragma("unroll") for (int k = 0; k < 2; ++k) \
        acc[ai][bj][m][n] = __builtin_amdgcn_mfma_f32_16x16x32_bf16(Bt[n][k], At[m][k], acc[ai][bj][m][n], 0, 0, 0); __builtin_amdgcn_s_setprio(0); } while (0)
#define PG8_WAIT_V(n) asm volatile("s_waitcnt vmcnt(" #n ")" ::: "memory")
#define PG8_WAIT_L(n) asm volatile("s_waitcnt lgkmcnt(" #n ")" ::: "memory")
#define PG8_BAR __builtin_amdgcn_s_barrier()
#define PG8_SCHED __builtin_amdgcn_sched_barrier(0)
    Unit cur, nxt; int ui = 0;
    if (!S.next(0, cur)) return;
    f32x4 acc[2][2][4][2];
#pragma unroll
    for (int a = 0; a < 2; ++a)
#pragma unroll
        for (int b = 0; b < 2; ++b)
#pragma unroll
            for (int m = 0; m < 4; ++m)
#pragma unroll
                for (int n = 0; n < 2; ++n) acc[a][b][m][n] = (f32x4){0.f, 0.f, 0.f, 0.f};
    bf16x8 At[4][2], B0[2][2], B1[2][2];
    const char* cA = (const char*)g.A + (size_t)cur.pm * tstep; const char* cB = (const char*)g.Bt + (size_t)cur.pn * tstep;
    S.a_ready(cur);
    if constexpr (SP2) {
        PG8_STAGE(PG8_SB(0, 0), cB, voffB); PG8_STAGE(PG8_SB(0, 1), cB + hstep, voffB); PG8_STAGE(PG8_SA(0, 0), cA, voffA); PG8_STAGE(PG8_SA(0, 1), cA + hstep, voffA);
        if (wr == 1) PG8_BAR;
        PG8_WAIT_V(2); PG8_BAR;
        PG8_STAGE(PG8_SB(1, 0), cB + kstep, voffB); PG8_STAGE(PG8_SA(1, 0), cA + kstep, voffA); PG8_STAGE(PG8_SB(1, 1), cB + hstep + kstep, voffB);
        PG8_WAIT_V(6); PG8_BAR;
    } else {
        PG8_STAGE(PG8_SB(0, 0), cB, voffB); PG8_STAGE(PG8_SA(0, 0), cA, voffA); PG8_STAGE(PG8_SB(0, 1), cB + hstep, voffB); PG8_STAGE(PG8_SA(0, 1), cA + hstep, voffA);
        if (wr == 1) PG8_BAR;
        PG8_WAIT_V(4); PG8_BAR;
        PG8_STAGE(PG8_SB(1, 0), cB + kstep, voffB); PG8_STAGE(PG8_SA(1, 0), cA + kstep, voffA); PG8_STAGE(PG8_SB(1, 1), cB + hstep + kstep, voffB);
        PG8_WAIT_V(6); PG8_BAR;
    }
    for (;;) {
        const bool has_next = S.next(ui + 1, nxt);
        const char* nA = has_next ? (const char*)g.A + (size_t)nxt.pm * tstep : cA; const char* nB = has_next ? (const char*)g.Bt + (size_t)nxt.pn * tstep : cB;
        for (int t = 0; t < nt; t += 2) {
            const bool last = (t == nt - 2);
            const char* a1 = cA + (size_t)(t + 1) * kstep;
            const char* a2 = last ? nA : cA + (size_t)(t + 2) * kstep; const char* b2 = last ? nB : cB + (size_t)(t + 2) * kstep;
            const char* a3 = a2 + kstep; const char* b3 = b2 + kstep;
            if (last && has_next) S.a_ready(nxt);
            if constexpr (SP2) {
            PG8_LDB(B0, 0, 0); PG8_LDB(B1, 0, 1); PG8_SCHED; PG8_LDA(At, 0, 0); PG8_STAGE(PG8_SA(1, 1), a1 + hstep, voffA);
            PG8_WAIT_V(8); PG8_WAIT_L(0); PG8_BAR; PG8_MMA(0, 0, At, B0); PG8_MMA(0, 1, At, B1); PG8_BAR; PG8_SCHED;
            PG8_LDA(At, 0, 1); PG8_STAGE(PG8_SB(0, 0), b2, voffB); PG8_STAGE(PG8_SB(0, 1), b2 + hstep, voffB); PG8_STAGE(PG8_SA(0, 0), a2, voffA);
            PG8_WAIT_V(8); PG8_WAIT_L(0); PG8_BAR; PG8_MMA(1, 0, At, B0); PG8_MMA(1, 1, At, B1); PG8_BAR; PG8_SCHED;
            PG8_LDB(B0, 1, 0); PG8_LDB(B1, 1, 1); PG8_SCHED; PG8_LDA(At, 1, 0); PG8_STAGE(PG8_SA(0, 1), a2 + hstep, voffA);
            PG8_WAIT_V(8); PG8_WAIT_L(0); PG8_BAR; PG8_MMA(0, 0, At, B0); PG8_MMA(0, 1, At, B1); PG8_BAR; PG8_SCHED;
            PG8_LDA(At, 1, 1); PG8_STAGE(PG8_SB(1, 0), b3, voffB); PG8_STAGE(PG8_SB(1, 1), b3 + hstep, voffB); PG8_STAGE(PG8_SA(1, 0), a3, voffA);
            PG8_WAIT_V(8); PG8_WAIT_L(0); PG8_BAR; PG8_MMA(1, 0, At, B0); PG8_MMA(1, 1, At, B1); PG8_BAR; PG8_SCHED;
            } else {
            PG8_LDB(B0, 0, 0); PG8_SCHED; PG8_LDA(At, 0, 0); PG8_STAGE(PG8_SA(1, 1), a1 + hstep, voffA);
            PG8_WAIT_L(8); PG8_BAR; PG8_WAIT_L(0); PG8_MMA(0, 0, At, B0); PG8_BAR; PG8_SCHED;
            PG8_LDB(B1, 0, 1); PG8_STAGE(PG8_SB(0, 0), b2, voffB);
            PG8_BAR; PG8_WAIT_L(0); PG8_MMA(0, 1, At, B1); PG8_BAR;
            PG8_LDA(At, 0, 1); PG8_STAGE(PG8_SA(0, 0), a2, voffA);
            PG8_BAR; PG8_WAIT_L(0); PG8_MMA(1, 0, At, B0); PG8_BAR; PG8_SCHED;
            PG8_STAGE(PG8_SB(0, 1), b2 + hstep, voffB);
            PG8_WAIT_V(6); PG8_BAR; PG8_MMA(1, 1, At, B1); PG8_BAR;
            PG8_LDB(B0, 1, 0); PG8_SCHED; PG8_LDA(At, 1, 0); PG8_STAGE(PG8_SA(0, 1), a2 + hstep, voffA);
            PG8_WAIT_L(8); PG8_BAR; PG8_WAIT_L(0); PG8_MMA(0, 0, At, B0); PG8_BAR; PG8_SCHED;
            PG8_LDB(B1, 1, 1); PG8_STAGE(PG8_SB(1, 0), b3, voffB);
            PG8_BAR; PG8_WAIT_L(0); PG8_MMA(0, 1, At, B1); PG8_BAR;
            PG8_LDA(At, 1, 1); PG8_STAGE(PG8_SA(1, 0), a3, voffA);
            PG8_BAR; PG8_WAIT_L(0); PG8_MMA(1, 0, At, B0); PG8_BAR; PG8_SCHED;
            PG8_STAGE(PG8_SB(1, 1), b3 + hstep, voffB);
            PG8_WAIT_V(6); PG8_BAR; PG8_MMA(1, 1, At, B1); PG8_BAR;
            }
        }
        if constexpr (ALIGN_EPI) { if (wr == 0) PG8_BAR; }
        if constexpr (!Epi::AFTER_DRAIN) { E(acc, cur, wr, wc, fr, fq); S.done(cur); }
        if (!has_next) break;
#pragma unroll
        for (int a = 0; a < 2; ++a)
#pragma unroll
            for (int b = 0; b < 2; ++b)
#pragma unroll
                for (int m = 0; m < 4; ++m)
#pragma unroll
                    for (int n = 0; n < 2; ++n) acc[a][b][m][n] = (f32x4){0.f, 0.f, 0.f, 0.f};
        cur = nxt; cA = nA; cB = nB; ++ui;
        if constexpr (ALIGN_EPI) { if (wr == 1) PG8_BAR; }
    }
    PG8_WAIT_V(0);
    if constexpr (!ALIGN_EPI) { if (wr == 0) PG8_BAR; }
    PG8_BAR;
    if constexpr (Epi::AFTER_DRAIN) { E.fused(acc, cur, wr, wc, fr, fq, lds, wid, lane); S.done(cur); }
#undef PG8_SA
#undef PG8_SB
#undef PG8_STAGE
#undef PG8_LDA
#undef PG8_LDB
#undef PG8_MMA
#undef PG8_WAIT_V
#undef PG8_WAIT_L
#undef PG8_BAR
#undef PG8_SCHED
}
}

#ifdef TA
constexpr bool defined_TA = true;
#else
constexpr bool defined_TA = false;
#endif
#ifdef TB
constexpr bool defined_TB = true;
#else
constexpr bool defined_TB = false;
#endif
#define LAS __attribute__((address_space(3)))
typedef unsigned short bf16_t;
typedef short bf16x8 __attribute__((ext_vector_type(8)));
typedef short s16x4 __attribute__((ext_vector_type(4)));
typedef float f32x4 __attribute__((ext_vector_type(4)));
typedef float f32x16 __attribute__((ext_vector_type(16)));
typedef unsigned u32x4 __attribute__((ext_vector_type(4)));
typedef unsigned u32x2 __attribute__((ext_vector_type(2)));
using pg8::Unit;

constexpr int T_ALL = 49152, T_PROMPT = 32768, L_P = 4096, L_S = 16384, DM = 1024, DFF = 2816, NBATCH = 9;
constexpr int AB_IN = 2304, CD_IN = 2560;
constexpr float C2 = 0.18033688011112042f;
constexpr float LOG2E = 1.4426950408889634f;
constexpr int NPHASE = 31;

__device__ __forceinline__ int otid() { int t = threadIdx.x; asm volatile("" : "+v"(t)); return t; }
__device__ __forceinline__ int batch_of(int row) { return row < T_PROMPT ? (row >> 12) : 8; }
__device__ __forceinline__ int seq0_of(int b) { return b < 8 ? b * L_P : T_PROMPT; }
__device__ __forceinline__ int seqlen_of(int b) { return b < 8 ? L_P : L_S; }
__device__ __forceinline__ unsigned pk_bf16(float lo, float hi) {
    typedef float f2_t __attribute__((ext_vector_type(2))); typedef __bf16 b2_t __attribute__((ext_vector_type(2)));
    f2_t v = {lo, hi}; b2_t b = __builtin_convertvector(v, b2_t); return __builtin_bit_cast(unsigned, b);
}
__device__ __forceinline__ bf16_t f2bf(float x) { return (bf16_t)(pk_bf16(x, 0.f) & 0xffffu); }
__device__ __forceinline__ float bf2f(bf16_t v) { return __uint_as_float((unsigned)v << 16); }
__device__ __forceinline__ float wave_sum(float v) {
#pragma unroll
    for (int o = 1; o < 64; o <<= 1) v += __shfl_xor(v, o);
    return v;
}
__device__ __forceinline__ float fast_exp2(float x) { return __builtin_amdgcn_exp2f(x); }
__device__ __forceinline__ float silu_f(float a) { return a * __builtin_amdgcn_rcpf(1.f + fast_exp2(-a * LOG2E)); }

constexpr size_t MiB = 1u << 20;
constexpr size_t WS_MOD = 1 * MiB;
constexpr size_t WS_BAR = 65536;
constexpr size_t WS_ROPE = 2 * MiB;
constexpr size_t WS_W = 4 * MiB;
constexpr size_t SZ_WINAB = (size_t)AB_IN * DM * 2, SZ_WOUT = (size_t)DM * DM * 2, SZ_WINCD = (size_t)CD_IN * DM * 2, SZ_W13 = (size_t)2 * DFF * DM * 2, SZ_W2 = (size_t)DM * DFF * 2;
constexpr size_t WS_WINAB = WS_W, WS_WOUTAB = WS_WINAB + 2 * SZ_WINAB, WS_WINCD = WS_WOUTAB + 2 * SZ_WOUT, WS_WOUTCD = WS_WINCD + 2 * SZ_WINCD,
                 WS_W13 = WS_WOUTCD + 2 * SZ_WOUT, WS_W2 = WS_W13 + 4 * SZ_W13, WS_WEND = WS_W2 + 4 * SZ_W2;
static_assert(WS_WEND <= 100 * MiB, "weights region");
constexpr size_t WS_H = 100 * MiB;
constexpr size_t WS_Z = 196 * MiB;
constexpr size_t WS_STASH = 460 * MiB;
constexpr size_t WS_NEED = 492 * MiB;

constexpr int LDS_BYTES = 131072 + 1024;

struct Args { const float* in[28]; float* out; unsigned char* ws; int ph_lo, ph_hi; };

struct EpiInAB {
    static constexpr bool PERM = true, AFTER_DRAIN = false;
    bf16_t* Z; const float* qg; const float* kg; const float* rope;
    __device__ __forceinline__ void operator()(const f32x4 (&acc)[2][2][4][2], const Unit& u, int wr, int wc, int fr, int fq) const {
        const int pn = u.pn;
        const int lcol = pn * 256 + wc * 64 + fq * 8;
        const bool isq = (pn == 6 || pn == 7), isk = (pn == 8 && wc < 2);
        const float* gsrc = isq ? qg : kg;
        f32x4 gv[2][2];
#pragma unroll
        for (int bj = 0; bj < 2; ++bj)
#pragma unroll
            for (int n = 0; n < 2; ++n) gv[bj][n] = *(const f32x4*)(gsrc + bj * 32 + fq * 8 + n * 4);
        const float qs = (pn < 2 || isq) ? C2 : 1.f;
#pragma unroll
        for (int ai = 0; ai < 2; ++ai)
#pragma unroll
            for (int m = 0; m < 4; ++m) {
                const int row = u.pm * 256 + ai * 128 + wr * 64 + m * 16 + fr;
                f32x4 v[2][2];
#pragma unroll
                for (int bj = 0; bj < 2; ++bj)
#pragma unroll
                    for (int n = 0; n < 2; ++n) v[bj][n] = acc[ai][bj][m][n];
                if (isq || isk) {
                    float ss = 0.f;
#pragma unroll
                    for (int bj = 0; bj < 2; ++bj)
#pragma unroll
                        for (int n = 0; n < 2; ++n) ss += (v[bj][n][0] * v[bj][n][0] + v[bj][n][1] * v[bj][n][1]) + (v[bj][n][2] * v[bj][n][2] + v[bj][n][3] * v[bj][n][3]);
                    ss += __shfl_xor(ss, 16); ss += __shfl_xor(ss, 32);
                    const float rstd = __builtin_amdgcn_rsqf(ss * (1.f / 64.f) + 1e-6f);
                    const int t = row < T_PROMPT ? (row & (L_P - 1)) : (row - T_PROMPT);
                    const int prow = t >> 6, pcol = t & 63;
#pragma unroll
                    for (int bj = 0; bj < 2; ++bj) {
                        const float* rp = rope + ((bj == 0 ? prow : pcol) * 16 + fq * 4) * 2;
#pragma unroll
                        for (int n = 0; n < 2; ++n) {
                            const f32x4 cs = *(const f32x4*)(rp + n * 4);
                            const f32x4 y = v[bj][n] * rstd * gv[bj][n];
                            f32x4 o;
                            o[0] = y[0] * cs[0] - y[1] * cs[1]; o[1] = y[0] * cs[1] + y[1] * cs[0];
                            o[2] = y[2] * cs[2] - y[3] * cs[3]; o[3] = y[2] * cs[3] + y[3] * cs[2];
                            v[bj][n] = o;
                        }
                    }
                }
                bf16_t* zp = Z + (size_t)row * AB_IN + lcol;
#pragma unroll
                for (int bj = 0; bj < 2; ++bj) {
                    const f32x4 a = v[bj][0] * qs, b = v[bj][1] * qs;
                    u32x4 w; w.x = pk_bf16(a[0], a[1]); w.y = pk_bf16(a[2], a[3]); w.z = pk_bf16(b[0], b[1]); w.w = pk_bf16(b[2], b[3]);
                    *(u32x4*)(zp + bj * 32) = w;
                }
            }
    }
};
struct EpiInCD {
    static constexpr bool PERM = true, AFTER_DRAIN = false;
    bf16_t* Z; unsigned* nrm;
    __device__ __forceinline__ void operator()(const f32x4 (&acc)[2][2][4][2], const Unit& u, int wr, int wc, int fr, int fq) const {
        const int pn = u.pn;
        const int lcol = pn * 256 + wc * 64 + fq * 8;
        const float qs = (pn == 4 || pn == 5) ? C2 : 1.f;
        if (pn >= 4 && pn < 8) {
            float mx = 0.f;
#pragma unroll
            for (int ai = 0; ai < 2; ++ai)
#pragma unroll
                for (int m = 0; m < 4; ++m) {
                    float ss = 0.f;
#pragma unroll
                    for (int bj = 0; bj < 2; ++bj)
#pragma unroll
                        for (int n = 0; n < 2; ++n) { const f32x4 v = acc[ai][bj][m][n] * qs; ss += (v[0] * v[0] + v[1] * v[1]) + (v[2] * v[2] + v[3] * v[3]); }
                    ss += __shfl_xor(ss, 16); ss += __shfl_xor(ss, 32);
                    mx = fmaxf(mx, ss);
                }
            mx = fmaxf(mx, __shfl_xor(mx, 1)); mx = fmaxf(mx, __shfl_xor(mx, 2)); mx = fmaxf(mx, __shfl_xor(mx, 4)); mx = fmaxf(mx, __shfl_xor(mx, 8));
            if (fr == 0 && fq == 0) atomicMax(nrm + (pn - 4) * 4 + wc, __float_as_uint(mx));
        }
#pragma unroll
        for (int ai = 0; ai < 2; ++ai)
#pragma unroll
            for (int m = 0; m < 4; ++m) {
                const int row = u.pm * 256 + ai * 128 + wr * 64 + m * 16 + fr;
                bf16_t* zp = Z + (size_t)row * CD_IN + lcol;
#pragma unroll
                for (int bj = 0; bj < 2; ++bj) {
                    const f32x4 a = acc[ai][bj][m][0] * qs, b = acc[ai][bj][m][1] * qs;
                    u32x4 w; w.x = pk_bf16(a[0], a[1]); w.y = pk_bf16(a[2], a[3]); w.z = pk_bf16(b[0], b[1]); w.w = pk_bf16(b[2], b[3]);
                    *(u32x4*)(zp + bj * 32) = w;
                }
            }
    }
};
template <bool FIRST>
struct EpiRes {
    static constexpr bool PERM = true, AFTER_DRAIN = false;
    const float* base_p; const float* base_s; bf16_t* xb; const float* gate;
    bf16_t* xw;
    __device__ __forceinline__ void operator()(const f32x4 (&acc)[2][2][4][2], const Unit& u, int wr, int wc, int fr, int fq) const {
        const int col0 = u.pn * 256 + wc * 32 + fq * 8;
        const int b = batch_of(u.pm * 256);
        const float* gp = gate + b * 6144 + col0;
        f32x4 g1[2][2];
#pragma unroll
        for (int bj = 0; bj < 2; ++bj)
#pragma unroll
            for (int n = 0; n < 2; ++n) g1[bj][n] = *(const f32x4*)(gp + bj * 128 + n * 4) + 1.f;
#pragma unroll
        for (int ai = 0; ai < 2; ++ai) {
            const int row0 = u.pm * 256 + ai * 128 + wr * 64 + fr;
            bf16_t* op = xb + (size_t)row0 * DM + col0; bf16_t* ow = xw + (size_t)row0 * DM + col0;
            if constexpr (FIRST) {
                const float* bp = (row0 < T_PROMPT ? base_p + (size_t)row0 * DM : base_s + (size_t)(row0 - T_PROMPT) * DM) + col0;
#pragma unroll
                for (int mh = 0; mh < 4; mh += 2) {
                    f32x4 xv[2][2][2];
#pragma unroll
                    for (int m = 0; m < 2; ++m)
#pragma unroll
                        for (int bj = 0; bj < 2; ++bj)
#pragma unroll
                            for (int n = 0; n < 2; ++n) xv[m][bj][n] = *(const f32x4*)(bp + (size_t)((mh + m) * 16) * DM + bj * 128 + n * 4);
#pragma unroll
                    for (int m = 0; m < 2; ++m)
#pragma unroll
                        for (int bj = 0; bj < 2; ++bj) {
                            const f32x4 a = xv[m][bj][0] + g1[bj][0] * acc[ai][bj][mh + m][0], c = xv[m][bj][1] + g1[bj][1] * acc[ai][bj][mh + m][1];
                            u32x4 w; w.x = pk_bf16(a[0], a[1]); w.y = pk_bf16(a[2], a[3]); w.z = pk_bf16(c[0], c[1]); w.w = pk_bf16(c[2], c[3]);
                            *(u32x4*)(ow + (size_t)((mh + m) * 16) * DM + bj * 128) = w;
                        }
                }
            } else {
                u32x4 xv[4][2];
#pragma unroll
                for (int m = 0; m < 4; ++m)
#pragma unroll
                    for (int bj = 0; bj < 2; ++bj) xv[m][bj] = *(const u32x4*)(op + (size_t)(m * 16) * DM + bj * 128);
#pragma unroll
                for (int m = 0; m < 4; ++m)
#pragma unroll
                    for (int bj = 0; bj < 2; ++bj) {
                        const u32x4 x = xv[m][bj];
                        const f32x4 x0 = {__uint_as_float(x.x << 16), __uint_as_float(x.x & 0xffff0000u), __uint_as_float(x.y << 16), __uint_as_float(x.y & 0xffff0000u)};
                        const f32x4 x1 = {__uint_as_float(x.z << 16), __uint_as_float(x.z & 0xffff0000u), __uint_as_float(x.w << 16), __uint_as_float(x.w & 0xffff0000u)};
                        const f32x4 a = x0 + g1[bj][0] * acc[ai][bj][m][0], c = x1 + g1[bj][1] * acc[ai][bj][m][1];
                        u32x4 w; w.x = pk_bf16(a[0], a[1]); w.y = pk_bf16(a[2], a[3]); w.z = pk_bf16(c[0], c[1]); w.w = pk_bf16(c[2], c[3]);
                        *(u32x4*)(ow + (size_t)(m * 16) * DM + bj * 128) = w;
                    }
            }
        }
    }
};
struct EpiResAt {
    static constexpr bool PERM = true, AFTER_DRAIN = false;
    float* out; const float* gate;
    __device__ __forceinline__ void operator()(const f32x4 (&acc)[2][2][4][2], const Unit& u, int wr, int wc, int fr, int fq) const {
        const int col0 = u.pn * 256 + wc * 32 + fq * 8;
        const int b = batch_of(u.pm * 256);
        const float* gp = gate + b * 6144 + col0;
        f32x4 g1[2][2];
#pragma unroll
        for (int bj = 0; bj < 2; ++bj)
#pragma unroll
            for (int n = 0; n < 2; ++n) g1[bj][n] = *(const f32x4*)(gp + bj * 128 + n * 4) + 1.f;
#pragma unroll
        for (int ai = 0; ai < 2; ++ai)
#pragma unroll
            for (int m = 0; m < 4; ++m) {
                float* op = out + (size_t)(u.pm * 256 + ai * 128 + wr * 64 + m * 16 + fr) * DM + col0;
#pragma unroll
                for (int bj = 0; bj < 2; ++bj)
#pragma unroll
                    for (int n = 0; n < 2; ++n) {
                        const f32x4 v = g1[bj][n] * acc[ai][bj][m][n];
#pragma unroll
                        for (int e = 0; e < 4; ++e) unsafeAtomicAdd(op + bj * 128 + n * 4 + e, v[e]);
                    }
            }
    }
};
struct EpiUp {
    static constexpr bool PERM = true, AFTER_DRAIN = false;
    bf16_t* U;
    __device__ __forceinline__ void operator()(const f32x4 (&acc)[2][2][4][2], const Unit& u, int wr, int wc, int fr, int fq) const {
        const int col0 = u.pn * 128 + wc * 32 + fq * 8;
#pragma unroll
        for (int ai = 0; ai < 2; ++ai)
#pragma unroll
            for (int m = 0; m < 4; ++m) {
                const int row = u.pm * 256 + ai * 128 + wr * 64 + m * 16 + fr;
                f32x4 r[2];
#pragma unroll
                for (int n = 0; n < 2; ++n) {
                    const f32x4 a = acc[ai][0][m][n], g = acc[ai][1][m][n];
                    r[n][0] = silu_f(a[0]) * g[0]; r[n][1] = silu_f(a[1]) * g[1]; r[n][2] = silu_f(a[2]) * g[2]; r[n][3] = silu_f(a[3]) * g[3];
                }
                u32x4 w; w.x = pk_bf16(r[0][0], r[0][1]); w.y = pk_bf16(r[0][2], r[0][3]); w.z = pk_bf16(r[1][0], r[1][1]); w.w = pk_bf16(r[1][2], r[1][3]);
                *(u32x4*)(U + (size_t)row * DFF + col0) = w;
            }
    }
};

constexpr int KBUF = 8192, ATT_TAB = 65536;
#ifndef PIPE128
#define PIPE128 1
#endif
__device__ __forceinline__ s16x4 tr_read(const LAS unsigned char* p) {
    typedef short v4i16_t __attribute__((ext_vector_type(4)));
    return __builtin_bit_cast(s16x4, __builtin_amdgcn_ds_read_tr16_b64_v4i16((LAS v4i16_t*)p));
}
__device__ __forceinline__ int crow(int r, int hi) { return (r & 3) + 8 * (r >> 2) + 4 * hi; }

__device__ __forceinline__ void glds16(const void* gsrc, unsigned lds_dst) {
    unsigned keep;
    asm volatile("s_mov_b32 %0, m0\n\ts_mov_b32 m0, %2\n\ts_nop 0\n\tglobal_load_lds_dwordx4 %1, off\n\ts_mov_b32 m0, %0" : "=&s"(keep) : "v"(gsrc), "s"(lds_dst) : "memory");
}
template <bool SPLIT>
__device__ __forceinline__ void qk_tile(const LAS unsigned char* Ks, const bf16x8 (&qr)[4], f32x16& s0, f32x16& s1) {
    const f32x16 zero16 = {0.f, 0.f, 0.f, 0.f, 0.f, 0.f, 0.f, 0.f, 0.f, 0.f, 0.f, 0.f, 0.f, 0.f, 0.f, 0.f};
    s0 = zero16; s1 = zero16;
#pragma unroll
    for (int d0 = 0; d0 < 4; ++d0) {
        const bf16x8 b0 = *(const LAS bf16x8*)(Ks + d0 * 256);
        const bf16x8 b1 = *(const LAS bf16x8*)(Ks + d0 * 256 + 4096);
        s0 = __builtin_amdgcn_mfma_f32_32x32x16_bf16(b0, qr[d0], s0, 0, 0, 0);
        s1 = __builtin_amdgcn_mfma_f32_32x32x16_bf16(b1, qr[d0], s1, 0, 0, 0);
        if (SPLIT && d0 == 1) __builtin_amdgcn_sched_barrier(0);
    }
}
__device__ __forceinline__ void qk_tile_c(const LAS unsigned char* Ks, const bf16x8 (&qr)[4], f32x16& s0, f32x16& s1, const f32x16& cinit) {
#pragma unroll
    for (int d0 = 0; d0 < 4; ++d0) {
        const bf16x8 b0 = *(const LAS bf16x8*)(Ks + d0 * 256);
        const bf16x8 b1 = *(const LAS bf16x8*)(Ks + d0 * 256 + 4096);
        s0 = __builtin_amdgcn_mfma_f32_32x32x16_bf16(b0, qr[d0], d0 == 0 ? cinit : s0, 0, 0, 0);
        s1 = __builtin_amdgcn_mfma_f32_32x32x16_bf16(b1, qr[d0], d0 == 0 ? cinit : s1, 0, 0, 0);
    }
}
template <int MODE>
__device__ __forceinline__ void apply_bias(f32x16& s0, f32x16& s1, int t, int hi, float slope2, int qpos, const LAS float* na_tab, int na_d0, int na_qc, int na_cs) {
    if constexpr (MODE == 1 && !defined_TA) {
        const float kbf = (float)(t * 64 + 4 * hi - qpos);
#pragma unroll
        for (int i = 0; i < 16; ++i) {
            const float c = (float)((i & 3) + 8 * (i >> 2));
            s0[i] = fmaf(-slope2, fabsf(kbf + c), s0[i]);
            s1[i] = fmaf(-slope2, fabsf(kbf + (c + 32.f)), s1[i]);
        }
    }
    if constexpr (MODE == 2) {
        const volatile LAS float* tb = na_tab + (t + na_d0) * 31 + (79 - na_qc + 4 * hi);
        const int cb = 4 * hi - na_cs;
        float bv0[16], bv1[16];
#pragma unroll
        for (int i = 0; i < 16; ++i) { const int c = (i & 3) + 8 * (i >> 2); bv0[i] = tb[c]; bv1[i] = tb[c + 32]; }
#pragma unroll
        for (int i = 0; i < 16; ++i) {
            const int c = (i & 3) + 8 * (i >> 2);
            s0[i] = ((unsigned)(cb + c) < 16u) ? s0[i] + bv0[i] : -1e30f;
            s1[i] = ((unsigned)(cb + c + 32) < 16u) ? s1[i] + bv1[i] : -1e30f;
        }
    }
}
template <int NDB>
__device__ __forceinline__ void max_rescale(f32x16& s0, f32x16& s1, f32x16 (&o)[NDB], float& mref, float& lacc, int hi) {
    constexpr float THR = 6.f;
#pragma unroll
    for (int i = 0; i < 16; ++i) { s0[i] -= mref; s1[i] -= mref; }
    float ra = fmaxf(fmaxf(s0[0], s1[0]), s0[1]), rb = fmaxf(fmaxf(s1[1], s0[2]), s1[2]);
#pragma unroll
    for (int i = 3; i < 15; i += 2) { ra = fmaxf(fmaxf(ra, s0[i]), s1[i]); rb = fmaxf(fmaxf(rb, s0[i + 1]), s1[i + 1]); }
    float rm = fmaxf(fmaxf(ra, rb), fmaxf(s0[15], s1[15]));
    rm = fmaxf(rm, __shfl_xor(rm, 32));
    if (__any(rm > THR)) {
        const float dl = fmaxf(rm, 0.f);
        const float f = fast_exp2(-dl);
        lacc *= f; mref += dl;
#pragma unroll
        for (int i = 0; i < 16; ++i) { s0[i] -= dl; s1[i] -= dl; }
#pragma unroll
        for (int r = 0; r < 16; ++r) {
            const float fq_ = __shfl(f, crow(r, hi));
#pragma unroll
            for (int d = 0; d < NDB; ++d) o[d][r] *= fq_;
        }
    }
}
template <int NDB>
__device__ __forceinline__ void max_rescale_c(f32x16& s0, f32x16& s1, f32x16 (&o)[NDB], float& mref, float& lacc, int hi, f32x16& negm) {
    constexpr float THR = 6.f;
    float ra = fmaxf(fmaxf(s0[0], s1[0]), s0[1]), rb = fmaxf(fmaxf(s1[1], s0[2]), s1[2]);
#pragma unroll
    for (int i = 3; i < 15; i += 2) { ra = fmaxf(fmaxf(ra, s0[i]), s1[i]); rb = fmaxf(fmaxf(rb, s0[i + 1]), s1[i + 1]); }
    float rm = fmaxf(fmaxf(ra, rb), fmaxf(s0[15], s1[15]));
    rm = fmaxf(rm, __shfl_xor(rm, 32));
    if (__any(rm > THR)) {
        const float dl = fmaxf(rm, 0.f);
        const float f = fast_exp2(-dl);
        lacc *= f; mref += dl;
#pragma unroll
        for (int i = 0; i < 16; ++i) { s0[i] -= dl; s1[i] -= dl; negm[i] = -mref; }
        asm volatile("" : "+v"(negm));
#pragma unroll
        for (int r = 0; r < 16; ++r) {
            const float fq_ = __shfl(f, crow(r, hi));
#pragma unroll
            for (int d = 0; d < NDB; ++d) o[d][r] *= fq_;
        }
    }
}
template <int NDB>
__device__ __forceinline__ void softmax_pv(const LAS unsigned char* Vs, f32x16& s0, f32x16& s1, f32x16 (&o)[NDB], float& lacc) {
    float sum = 0.f;
#pragma unroll
    for (int i = 0; i < 16; ++i) { s0[i] = fast_exp2(s0[i]); s1[i] = fast_exp2(s1[i]); sum += s0[i] + s1[i]; }
    lacc += sum;
    bf16x8 pa[4];
    {
        u32x4 w;
        w.x = pk_bf16(s0[0], s0[1]); w.y = pk_bf16(s0[2], s0[3]); w.z = pk_bf16(s0[4], s0[5]); w.w = pk_bf16(s0[6], s0[7]); pa[0] = __builtin_bit_cast(bf16x8, w);
        w.x = pk_bf16(s0[8], s0[9]); w.y = pk_bf16(s0[10], s0[11]); w.z = pk_bf16(s0[12], s0[13]); w.w = pk_bf16(s0[14], s0[15]); pa[1] = __builtin_bit_cast(bf16x8, w);
        w.x = pk_bf16(s1[0], s1[1]); w.y = pk_bf16(s1[2], s1[3]); w.z = pk_bf16(s1[4], s1[5]); w.w = pk_bf16(s1[6], s1[7]); pa[2] = __builtin_bit_cast(bf16x8, w);
        w.x = pk_bf16(s1[8], s1[9]); w.y = pk_bf16(s1[10], s1[11]); w.z = pk_bf16(s1[12], s1[13]); w.w = pk_bf16(s1[14], s1[15]); pa[3] = __builtin_bit_cast(bf16x8, w);
    }
#pragma unroll
    for (int db = 0; db < NDB; ++db) {
#pragma unroll
        for (int i = 0; i < 4; ++i) {
            const s16x4 lo = tr_read(Vs + db * 4096 + i * 1024);
            const s16x4 hi4 = tr_read(Vs + db * 4096 + i * 1024 + 512);
            const bf16x8 vf = {lo[0], lo[1], lo[2], lo[3], hi4[0], hi4[1], hi4[2], hi4[3]};
            o[db] = __builtin_amdgcn_mfma_f32_32x32x16_bf16(pa[i], vf, o[db], 0, 0, 0);
        }
    }
}

template <int NOMAX>
__device__ __forceinline__ void step_hs(const LAS unsigned char* Ks, const LAS unsigned char* Vs, const bf16x8 (&qr)[4], f32x16& C0, f32x16& C1, f32x16& N0, f32x16& N1,
                                        f32x16 (&o)[2], float& mref, float& lacc, int hi, f32x16& negm) {
#define SBAR() __builtin_amdgcn_sched_barrier(0)
    bf16x8 kf[8];
#pragma unroll
    for (int c = 0; c < 8; ++c) kf[c] = *(const LAS bf16x8*)(Ks + (c & 3) * 256 + (c >> 2) * 4096);
    unsigned pw[16]; float sum = 0.f;
#define EXP2P(C, e, w) do { const float e0_ = fast_exp2(C[e]), e1_ = fast_exp2(C[(e) + 1]); sum += e0_ + e1_; pw[w] = pk_bf16(e0_, e1_); } while (0)
    SBAR();
#pragma unroll
    for (int j = 0; j < 8; ++j) {
        if (j < 4) N0 = __builtin_amdgcn_mfma_f32_32x32x16_bf16(kf[j], qr[j], j == 0 ? negm : N0, 0, 0, 0);
        else       N1 = __builtin_amdgcn_mfma_f32_32x32x16_bf16(kf[j], qr[j - 4], j == 4 ? negm : N1, 0, 0, 0);
        EXP2P(C0, 2 * j, j);
        SBAR();
    }
    s16x4 vlo[8], vhi[8];
#pragma unroll
    for (int j = 0; j < 4; ++j) { vlo[j] = tr_read(Vs + (j & 1) * 4096 + (j >> 1) * 1024); vhi[j] = tr_read(Vs + (j & 1) * 4096 + (j >> 1) * 1024 + 512); }
    float ra = -3.0e38f, rb = -3.0e38f;
    SBAR();
#pragma unroll
    for (int j = 0; j < 8; ++j) {
        if (j + 4 < 8) { const int jj = j + 4; vlo[jj] = tr_read(Vs + (jj & 1) * 4096 + (jj >> 1) * 1024); vhi[jj] = tr_read(Vs + (jj & 1) * 4096 + (jj >> 1) * 1024 + 512); }
        const bf16x8 vf = {vlo[j][0], vlo[j][1], vlo[j][2], vlo[j][3], vhi[j][0], vhi[j][1], vhi[j][2], vhi[j][3]};
        const int i = j >> 1;
        const u32x4 w = {pw[4 * i], pw[4 * i + 1], pw[4 * i + 2], pw[4 * i + 3]};
        const bf16x8 pa = __builtin_bit_cast(bf16x8, w);
        if (j & 1) o[1] = __builtin_amdgcn_mfma_f32_32x32x16_bf16(pa, vf, o[1], 0, 0, 0);
        else       o[0] = __builtin_amdgcn_mfma_f32_32x32x16_bf16(pa, vf, o[0], 0, 0, 0);
        if (j < 4) EXP2P(C1, 2 * j, 8 + j);
        if (j >= 2 && j < 6) EXP2P(C1, 8 + 2 * (j - 2), 12 + (j - 2));
        const int bs = (j & 3) * 4;
        if constexpr (!NOMAX) {
        if (j < 4) { ra = fmaxf(fmaxf(ra, N0[bs]), N0[bs + 1]); rb = fmaxf(fmaxf(rb, N0[bs + 2]), N0[bs + 3]); }
        else       { ra = fmaxf(fmaxf(ra, N1[bs]), N1[bs + 1]); rb = fmaxf(fmaxf(rb, N1[bs + 2]), N1[bs + 3]); }
        }
        SBAR();
    }
    lacc += sum;
#undef EXP2P
    if constexpr (NOMAX) return;
    float rm = fmaxf(ra, rb);
    rm = fmaxf(rm, __shfl_xor(rm, 32));
    if (__any(rm > 6.f)) {
        const float dl = fmaxf(rm, 0.f);
        const float f = fast_exp2(-dl);
        lacc *= f; mref += dl;
#pragma unroll
        for (int i = 0; i < 16; ++i) { N0[i] -= dl; N1[i] -= dl; negm[i] = -mref; }
        asm volatile("" : "+v"(negm));
#pragma unroll
        for (int r = 0; r < 16; ++r) {
            const float fq_ = __shfl(f, crow(r, hi));
            o[0][r] *= fq_; o[1][r] *= fq_;
        }
    }
#undef SBAR
}

__device__ __forceinline__ void step_hs128(const LAS unsigned char* Ks, const LAS unsigned char* Vs, const bf16x8 (&qr)[4], f32x16& C0, f32x16& C1, f32x16& N0, f32x16& N1,
                                           f32x16 (&o)[4], float& mref, float& lacc, int hi, float slope2, int qpos, int tn, f32x16& negm) {
#define SBAR() __builtin_amdgcn_sched_barrier(0)
#define KFRAG(c) (*(const LAS bf16x8*)(Ks + ((c) & 3) * 256 + ((c) >> 2) * 4096))
    bf16x8 kf[8];
    kf[0] = KFRAG(0); kf[1] = KFRAG(1);
    unsigned pw[16]; float sum = 0.f;
    SBAR();
#pragma unroll
    for (int j = 0; j < 8; ++j) {
        if (j + 2 < 8) kf[j + 2] = KFRAG(j + 2);
        if (j < 4) N0 = __builtin_amdgcn_mfma_f32_32x32x16_bf16(kf[j], qr[j], j == 0 ? negm : N0, 0, 0, 0);
        else       N1 = __builtin_amdgcn_mfma_f32_32x32x16_bf16(kf[j], qr[j - 4], j == 4 ? negm : N1, 0, 0, 0);
        const int bs = (j & 3) * 4;
        float e0, e1, e2, e3;
        if (j < 4) { e0 = fast_exp2(C0[bs]); e1 = fast_exp2(C0[bs + 1]); e2 = fast_exp2(C0[bs + 2]); e3 = fast_exp2(C0[bs + 3]); }
        else       { e0 = fast_exp2(C1[bs]); e1 = fast_exp2(C1[bs + 1]); e2 = fast_exp2(C1[bs + 2]); e3 = fast_exp2(C1[bs + 3]); }
        sum += (e0 + e1) + (e2 + e3);
        pw[2 * j] = pk_bf16(e0, e1); pw[2 * j + 1] = pk_bf16(e2, e3);
        SBAR();
    }
    lacc += sum;
    bf16x8 pa[4];
#pragma unroll
    for (int i = 0; i < 4; ++i) { u32x4 w = {pw[4 * i], pw[4 * i + 1], pw[4 * i + 2], pw[4 * i + 3]}; pa[i] = __builtin_bit_cast(bf16x8, w); }
    s16x4 vlo[16], vhi[16];
#define VOFFS(j) (((j) & 3) * 4096 + ((j) >> 2) * 1024)
    vlo[0] = tr_read(Vs + VOFFS(0)); vhi[0] = tr_read(Vs + VOFFS(0) + 512);
    vlo[1] = tr_read(Vs + VOFFS(1)); vhi[1] = tr_read(Vs + VOFFS(1) + 512);
    float ra = -3.0e38f, rb = -3.0e38f;
    const float kbf = (float)(tn * 64 + 4 * hi - qpos);
    SBAR();
#pragma unroll
    for (int j = 0; j < 16; ++j) {
        if (j + 2 < 16) { vlo[j + 2] = tr_read(Vs + VOFFS(j + 2)); vhi[j + 2] = tr_read(Vs + VOFFS(j + 2) + 512); }
        const bf16x8 vf = {vlo[j][0], vlo[j][1], vlo[j][2], vlo[j][3], vhi[j][0], vhi[j][1], vhi[j][2], vhi[j][3]};
        if ((j & 3) == 0)      o[0] = __builtin_amdgcn_mfma_f32_32x32x16_bf16(pa[j >> 2], vf, o[0], 0, 0, 0);
        else if ((j & 3) == 1) o[1] = __builtin_amdgcn_mfma_f32_32x32x16_bf16(pa[j >> 2], vf, o[1], 0, 0, 0);
        else if ((j & 3) == 2) o[2] = __builtin_amdgcn_mfma_f32_32x32x16_bf16(pa[j >> 2], vf, o[2], 0, 0, 0);
        else                   o[3] = __builtin_amdgcn_mfma_f32_32x32x16_bf16(pa[j >> 2], vf, o[3], 0, 0, 0);
        {
            const int e = (2 * j) & 15;
            const float c0 = (float)((e & 3) + 8 * (e >> 2) + (j >= 8 ? 32 : 0)), c1 = (float)(((e + 1) & 3) + 8 * ((e + 1) >> 2) + (j >= 8 ? 32 : 0));
            if (j < 8) {
                N0[e] = fmaf(-slope2, fabsf(kbf + c0), N0[e]); N0[e + 1] = fmaf(-slope2, fabsf(kbf + c1), N0[e + 1]);
                if (j & 1) rb = fmaxf(fmaxf(rb, N0[e]), N0[e + 1]); else ra = fmaxf(fmaxf(ra, N0[e]), N0[e + 1]);
            } else {
                N1[e] = fmaf(-slope2, fabsf(kbf + c0), N1[e]); N1[e + 1] = fmaf(-slope2, fabsf(kbf + c1), N1[e + 1]);
                if (j & 1) rb = fmaxf(fmaxf(rb, N1[e]), N1[e + 1]); else ra = fmaxf(fmaxf(ra, N1[e]), N1[e + 1]);
            }
        }
        SBAR();
    }
    float rm = fmaxf(ra, rb);
    rm = fmaxf(rm, __shfl_xor(rm, 32));
    if (__any(rm > 6.f)) {
        const float dl = fmaxf(rm, 0.f);
        const float f = fast_exp2(-dl);
        lacc *= f; mref += dl;
#pragma unroll
        for (int i = 0; i < 16; ++i) { N0[i] -= dl; N1[i] -= dl; negm[i] = -mref; }
        asm volatile("" : "+v"(negm));
#pragma unroll
        for (int r = 0; r < 16; ++r) {
            const float fq_ = __shfl(f, crow(r, hi));
            o[0][r] *= fq_; o[1][r] *= fq_; o[2][r] *= fq_; o[3][r] *= fq_;
        }
    }
#undef SBAR
#undef KFRAG
#undef VOFFS
}

template <int DV, int MODE, int NMAP, int NOMAX = 0>
__device__ __forceinline__ void flash_core(LAS unsigned char* lds, const bf16_t* __restrict__ Kg, int ldk, const bf16_t* __restrict__ Vg, int ldv, int nt,
                                           const bf16x8 (&qr)[4], f32x16 (&o)[DV / 32], float& ltot,
                                           float slope2, int qpos, int na_tlo, int na_d0, int na_qc) {
    constexpr int NDB = DV / 32, VBUF = DV * 128, KST = NMAP * KBUF, VOFF = 3 * KST, NOPS = NMAP + DV / 64;
    static_assert(NOPS == 2 || NOPS == 4, "counted waits below");
    const int tid = otid(), lane = tid & 63, r32 = lane & 31, hi = lane >> 5, wid = tid >> 6;
    const int mp = NMAP == 2 ? (wid >> 2) : 0;
    const int widu = __builtin_amdgcn_readfirstlane(wid);
    const unsigned lds0 = (unsigned)(uintptr_t)lds;
    const bf16_t* ksrc = Kg + (size_t)(widu * 8 + (lane & 7)) * ldk + ((lane >> 3) ^ ((widu >> 1) & 1)) * 8;
    const bf16_t* vsrc = Vg + (size_t)(16 * (widu & 3) + (lane >> 2)) * ldv + (widu >> 2) * 32 + (lane & 3) * 8;
    const unsigned kdst = lds0 + widu * 1024, vdst = lds0 + VOFF + (widu >> 2) * 4096 + (widu & 3) * 1024;
    const int kro = mp * KBUF + (r32 >> 3) * 1024 + (r32 & 7) * 16 + (hi ^ ((r32 >> 4) & 1)) * 128;
    const int vro = VOFF + (4 * hi + ((lane & 15) >> 2)) * 64 + ((lane >> 4) & 1) * 32 + (lane & 3) * 8;
    const f32x16 zero16 = {0.f, 0.f, 0.f, 0.f, 0.f, 0.f, 0.f, 0.f, 0.f, 0.f, 0.f, 0.f, 0.f, 0.f, 0.f, 0.f};
#pragma unroll
    for (int d = 0; d < NDB; ++d) o[d] = zero16;
    float mref = 0.f, lacc = 0.f;
    const int na_cs = MODE == 2 ? min(max(na_qc - 8, 0), 48) : 0;
    const LAS float* na_tab = (const LAS float*)(lds + ATT_TAB);
    const int ntm1 = nt - 1;
#define FL_DMAK(tt, st) do { const bf16_t* p_ = ksrc + (size_t)min((tt), ntm1) * 64 * ldk; glds16(p_, (unsigned)__builtin_amdgcn_readfirstlane(kdst + (st) * KST)); \
        if constexpr (NMAP == 2) glds16(p_ + 64, (unsigned)__builtin_amdgcn_readfirstlane(kdst + (st) * KST + KBUF)); } while (0)
#define FL_DMAV(tt, st) do { const bf16_t* p_ = vsrc + (size_t)min((tt), ntm1) * 64 * ldv; glds16(p_, (unsigned)__builtin_amdgcn_readfirstlane(vdst + (st) * VBUF)); \
        if constexpr (DV == 128) glds16(p_ + 64, (unsigned)__builtin_amdgcn_readfirstlane(vdst + (st) * VBUF + 8192)); } while (0)
#define FL_WB_ALL() asm volatile("s_waitcnt vmcnt(0) lgkmcnt(0)\n\ts_barrier" ::: "memory")
#define FL_WB_ONE() do { if constexpr (NOPS == 2) asm volatile("s_waitcnt vmcnt(2) lgkmcnt(0)\n\ts_barrier" ::: "memory"); else asm volatile("s_waitcnt vmcnt(4) lgkmcnt(0)\n\ts_barrier" ::: "memory"); } while (0)
#define FL_NEXT(s) ((s) == 2 ? 0 : (s) + 1)
#define FL_ACT(tt) (MODE != 2 || (unsigned)((tt) - na_tlo) < 8u)
    asm volatile("" :: "v"(qr[0]), "v"(qr[1]), "v"(qr[2]), "v"(qr[3]));
    FL_WB_ALL();
    if constexpr (DV == 128 && !PIPE128) {
        f32x16 s0, s1;
        FL_DMAK(0, 0); FL_DMAV(0, 0);
        FL_DMAK(1, 1); FL_DMAV(1, 1);
        FL_WB_ONE();
        int st = 0;
        for (int t = 0; t < nt; ++t) {
            const int st2 = (st == 0) ? 2 : st - 1;
            FL_DMAK(t + 2, st2); FL_DMAV(t + 2, st2);
            qk_tile<false>(lds + st * KST + kro, qr, s0, s1);
            apply_bias<MODE>(s0, s1, t, hi, slope2, qpos, na_tab, na_d0, na_qc, na_cs);
            max_rescale<NDB>(s0, s1, o, mref, lacc, hi);
            softmax_pv<NDB>(lds + st * VBUF + vro, s0, s1, o, lacc);
            FL_WB_ONE();
            st = FL_NEXT(st);
        }
    } else {
        FL_DMAK(0, 0); FL_DMAV(0, 0); FL_DMAK(1, 1);
        FL_DMAK(2, 2); FL_DMAV(1, 1);
        FL_WB_ONE();
        f32x16 sa0, sa1, sb0, sb1;
        sa0 = zero16; sa1 = zero16; sb0 = zero16; sb1 = zero16;
        if (FL_ACT(0)) {
            qk_tile<false>(lds + kro, qr, sa0, sa1);
            apply_bias<MODE>(sa0, sa1, 0, hi, slope2, qpos, na_tab, na_d0, na_qc, na_cs);
            if constexpr (!NOMAX) max_rescale<NDB>(sa0, sa1, o, mref, lacc, hi);
        }
        f32x16 negm;
#pragma unroll
        for (int i = 0; i < 16; ++i) negm[i] = -mref;
        asm volatile("" : "+v"(negm));
        asm volatile("s_waitcnt lgkmcnt(0)\n\ts_barrier" ::: "memory");
        int sg = 0;
#define FL_BODY(C0, C1, N0, N1, T) do { \
        const int t_ = (T); const int sg1_ = FL_NEXT(sg), sg2_ = FL_NEXT(sg1_); \
        FL_DMAK(t_ + 3, sg); FL_DMAV(t_ + 2, sg2_); \
        const bool actc_ = FL_ACT(t_), actn_ = FL_ACT(t_ + 1); \
        if constexpr (MODE == 0 && DV == 64) { step_hs<NOMAX>(lds + sg1_ * KST + kro, lds + sg * VBUF + vro, qr, C0, C1, N0, N1, o, mref, lacc, hi, negm); } \
        else if constexpr (MODE == 1 && DV == 128) { step_hs128(lds + sg1_ * KST + kro, lds + sg * VBUF + vro, qr, C0, C1, N0, N1, o, mref, lacc, hi, slope2, qpos, t_ + 1, negm); } else { \
        if (actn_) qk_tile_c(lds + sg1_ * KST + kro, qr, N0, N1, negm); \
        if (actc_) softmax_pv<NDB>(lds + sg * VBUF + vro, C0, C1, o, lacc); \
        if (actn_) { apply_bias<MODE>(N0, N1, t_ + 1, hi, slope2, qpos, na_tab, na_d0, na_qc, na_cs); max_rescale_c<NDB>(N0, N1, o, mref, lacc, hi, negm); } } \
        FL_WB_ONE(); sg = sg1_; } while (0)
        int t = 0;
        for (; t + 2 < nt; t += 2) { FL_BODY(sa0, sa1, sb0, sb1, t); FL_BODY(sb0, sb1, sa0, sa1, t + 1); }
        if (t + 1 < nt) {
            FL_BODY(sa0, sa1, sb0, sb1, t);
            if (FL_ACT(t + 1)) softmax_pv<NDB>(lds + sg * VBUF + vro, sb0, sb1, o, lacc);
        } else {
            if (FL_ACT(t)) softmax_pv<NDB>(lds + sg * VBUF + vro, sa0, sa1, o, lacc);
        }
    }
    FL_WB_ALL();
#undef FL_DMAK
#undef FL_DMAV
#undef FL_WB_ALL
#undef FL_WB_ONE
#undef FL_NEXT
#undef FL_ACT
#undef FL_BODY
    ltot = lacc + __shfl_xor(lacc, 32);
}

__device__ __forceinline__ void gqa_unit(LAS unsigned char* lds, const bf16_t* Z, bf16_t* O, const float* qg, const float* kg, int b, int hq, int qb) {
    const int tid = otid(), lane = tid & 63, r32 = lane & 31, hi = lane >> 5, wid = tid >> 6;
    const int seq0 = seq0_of(b), L = seqlen_of(b);
    const size_t qrow = (size_t)seq0 + qb * 256 + wid * 32;
    const bf16_t* Qp = Z + (qrow + r32) * AB_IN + 1536 + hq * 64 + hi * 8;
    bf16x8 qr[4];
#pragma unroll
    for (int d0 = 0; d0 < 4; ++d0) qr[d0] = *(const bf16x8*)(Qp + d0 * 16);
    const int kvh = hq >> 2;
    f32x16 o[2]; float ltot;
    float gq = fabsf(qg[lane]), gk = fabsf(kg[lane]);
#pragma unroll
    for (int s_ = 1; s_ < 64; s_ <<= 1) { gq = fmaxf(gq, __shfl_xor(gq, s_)); gk = fmaxf(gk, __shfl_xor(gk, s_)); }
    const bool bounded = __builtin_amdgcn_readfirstlane(64.f * C2 * 1.05f * gq * gk <= 40.f ? 1 : 0) != 0;
    if (bounded) flash_core<64, 0, 1, 1>(lds, Z + (size_t)seq0 * AB_IN + 2048 + kvh * 64, AB_IN, Z + (size_t)seq0 * AB_IN + 2176 + kvh * 64, AB_IN, L / 64, qr, o, ltot, 0.f, 0, 0, 0, 0);
    else         flash_core<64, 0, 1, 0>(lds, Z + (size_t)seq0 * AB_IN + 2048 + kvh * 64, AB_IN, Z + (size_t)seq0 * AB_IN + 2176 + kvh * 64, AB_IN, L / 64, qr, o, ltot, 0.f, 0, 0, 0, 0);
    const float linv = 1.f / ltot;
    bf16_t* Op = O + qrow * DM + 512 + hq * 64 + r32;
#pragma unroll
    for (int r = 0; r < 16; ++r) {
        const int q = crow(r, hi); const float li = __shfl(linv, q);
#pragma unroll
        for (int d = 0; d < 2; ++d) Op[(size_t)q * DM + 32 * d] = f2bf(o[d][r] * li);
    }
}
__device__ __forceinline__ void na_unit(LAS unsigned char* lds, const bf16_t* Z, bf16_t* O, const float* rpb  , int b, int h, int R4) {
    const int tid = otid(), lane = tid & 63, r32 = lane & 31, hi = lane >> 5, wid = tid >> 6;
    const int seq0 = seq0_of(b), rows = seqlen_of(b) >> 6;
    const int r = 4 * R4 + (wid >> 1), half = wid & 1;
    const int kr0 = min(max(4 * R4 - 4, 0), rows - 8), kr1 = min(max(4 * R4 + 3 - 4, 0), rows - 8) + 8;
    const int rs = min(max(r - 4, 0), rows - 8);
    __syncthreads();
    {
        LAS float* tab = (LAS float*)(lds + ATT_TAB);
        for (int i = tid; i < 640; i += 512) { const int idx = i - 64; tab[i] = (idx >= 0 && idx < 465) ? rpb[h * 465 + idx] * LOG2E : 0.f; }
    }
    const size_t qrow = (size_t)seq0 + 64 * r + 32 * half;
    const bf16_t* Qp = Z + (qrow + r32) * AB_IN + h * 64 + hi * 8;
    bf16x8 qr[4];
#pragma unroll
    for (int d0 = 0; d0 < 4; ++d0) qr[d0] = *(const bf16x8*)(Qp + d0 * 16);
    f32x16 o[2]; float ltot;
    const size_t krow = (size_t)seq0 + 64 * kr0;
    flash_core<64, 2, 1>(lds, Z + krow * AB_IN + 512 + h * 64, AB_IN, Z + krow * AB_IN + 1024 + h * 64, AB_IN, kr1 - kr0, qr, o, ltot, 0.f, 0, rs - kr0, kr0 - r + 7, 32 * half + r32);
    const float linv = 1.f / ltot;
    bf16_t* Op = O + qrow * DM + h * 64 + r32;
#pragma unroll
    for (int rr = 0; rr < 16; ++rr) {
        const int q = crow(rr, hi); const float li = __shfl(linv, q);
#pragma unroll
        for (int d = 0; d < 2; ++d) Op[(size_t)q * DM + 32 * d] = f2bf(o[d][rr] * li);
    }
}
__device__ __forceinline__ void diff_epilogue(LAS unsigned char* lds, bf16_t* O, const float* lq1, const float* lk1, const float* lq2, const float* lk2, const float* subg, int li_,
                                              int row0, int h, f32x16 (&o)[4], float ltot) {
    const float lam_init = __uint_as_float(__builtin_amdgcn_readfirstlane(li_ == 1 ? 0x3eb60549u : 0x3f0e59d5u));
    const int tid = otid(), lane = tid & 63, r32 = lane & 31, hi = lane >> 5, wid = tid >> 6;
    const int mp = wid >> 2, wq = wid & 3;
    const float lam = __expf(wave_sum(lq1[lane] * lk1[lane])) - __expf(wave_sum(lq2[lane] * lk2[lane])) + lam_init;
    const float linv = 1.f / ltot;
    LAS float* ex = (LAS float*)lds + wq * 4096 + lane;
    if (mp == 1) {
#pragma unroll
        for (int r = 0; r < 16; ++r) {
            const float li = __shfl(linv, crow(r, hi)) * lam;
#pragma unroll
            for (int d = 0; d < 4; ++d) ex[(d * 16 + r) * 64] = o[d][r] * li;
        }
    }
    __syncthreads();
    if (mp == 0) {
        float gsc[4];
#pragma unroll
        for (int d = 0; d < 4; ++d) gsc[d] = subg[32 * d + r32] * (1.f - lam_init);
        bf16_t* Op = O + ((size_t)row0 + wq * 32) * DM + 512 + h * 128 + r32;
#pragma unroll
        for (int r = 0; r < 16; ++r) {
            const float li = __shfl(linv, crow(r, hi));
            float v[4];
#pragma unroll
            for (int d = 0; d < 4; ++d) v[d] = o[d][r] * li - ex[(d * 16 + r) * 64];
            float ss = (v[0] * v[0] + v[1] * v[1]) + (v[2] * v[2] + v[3] * v[3]);
            ss += __shfl_xor(ss, 1); ss += __shfl_xor(ss, 2); ss += __shfl_xor(ss, 4); ss += __shfl_xor(ss, 8); ss += __shfl_xor(ss, 16);
            const float rstd = __builtin_amdgcn_rsqf(ss * (1.f / 128.f) + 1e-6f);
            const int q = crow(r, hi);
#pragma unroll
            for (int d = 0; d < 4; ++d) Op[(size_t)q * DM + 32 * d] = f2bf(v[d] * rstd * gsc[d]);
        }
    }
    __syncthreads();
}
__device__ __forceinline__ void diff_unit(LAS unsigned char* lds, const bf16_t* Z, bf16_t* O, const float* lq1, const float* lk1, const float* lq2, const float* lk2,
                                          const float* subg, int li_, const unsigned* nrm  , int b, int h, int qb) {
    const int tid = otid(), lane = tid & 63, r32 = lane & 31, hi = lane >> 5, wid = tid >> 6;
    const int mp = wid >> 2, wq = wid & 3;
    const int seq0 = seq0_of(b), L = seqlen_of(b);
    const float slope2 = exp2f(-2.f * (float)(h + 1)) * LOG2E;
    const float sm0 = sqrtf(__uint_as_float(nrm[2 * h]) * __uint_as_float(nrm[8 + 2 * h])), sm1 = sqrtf(__uint_as_float(nrm[2 * h + 1]) * __uint_as_float(nrm[8 + 2 * h + 1]));
    const float smax2 = fmaxf(sm0, sm1) * 1.02f;
    const float Dk = (40.f + 2.f * smax2) / slope2;
    const int q0 = qb * 128, ntall = L / 64;
    const int t_lo = max(0, (int)ceilf(((float)q0 - Dk - 63.f) * (1.f / 64.f)));
    const int t_hi = min(ntall - 1, (int)floorf(((float)(q0 + 127) + Dk) * (1.f / 64.f)));
    const size_t qrow = (size_t)seq0 + q0 + wq * 32;
    const int qpos = q0 + wq * 32 + r32 - 64 * t_lo;
    const bf16_t* Qp = Z + (qrow + r32) * CD_IN + 1024 + h * 128 + mp * 64 + hi * 8;
    bf16x8 qr[4];
#pragma unroll
    for (int d0 = 0; d0 < 4; ++d0) qr[d0] = *(const bf16x8*)(Qp + d0 * 16);
    f32x16 o[4]; float ltot;
    const size_t krow = (size_t)seq0 + 64 * t_lo;
    flash_core<128, 1, 2>(lds, Z + krow * CD_IN + 1536 + h * 128, CD_IN, Z + krow * CD_IN + 2048 + h * 128, CD_IN, t_hi - t_lo + 1, qr, o, ltot, slope2, qpos, 0, 0, 0);
    diff_epilogue(lds, O, lq1, lk1, lq2, lk2, subg, li_, seq0 + q0, h, o, ltot);
}
__device__ __forceinline__ void conv_unit(LAS unsigned char* lds, const bf16_t* Z, bf16_t* O, const float* cw, const float* cb, const float* lg, const float* lb, int unit) {
    const int tid = otid(), lane = tid & 63, wid = tid >> 6;
    const int t0 = unit * 32, b = batch_of(t0), seq0 = seq0_of(b), send = seq0 + seqlen_of(b);
    const int c = tid;
    float w[31];
#pragma unroll
    for (int j = 0; j < 31; ++j) w[j] = cw[j * 512 + c];
    typedef float f32x2_t __attribute__((ext_vector_type(2)));
    f32x2_t wp[32];
#pragma unroll
    for (int m = 0; m < 32; ++m) wp[m] = (f32x2_t){m <= 30 ? w[m <= 30 ? m : 0] : 0.f, m >= 1 ? w[m >= 1 ? m - 1 : 0] : 0.f};
    f32x2_t acc2[16];
    const float bias = cb[c];
#pragma unroll
    for (int p = 0; p < 16; ++p) acc2[p] = (f32x2_t){bias, bias};
#pragma unroll
    for (int i = 0; i < 62; ++i) {
        const int tok = t0 - 15 + i;
        float uval = 0.f;
        if (tok >= seq0 && tok < send) {
            const float a = bf2f(Z[(size_t)tok * CD_IN + c]), g = bf2f(Z[(size_t)tok * CD_IN + 512 + c]);
            uval = a * __builtin_amdgcn_rcpf(1.f + fast_exp2(-g * LOG2E));
        }
        const f32x2_t uu = {uval, uval};
#pragma unroll
        for (int p = 0; p < 16; ++p) { if (i - 2 * p >= 0 && i - 2 * p <= 31) acc2[p] = __builtin_elementwise_fma(wp[i - 2 * p], uu, acc2[p]); }
    }
    float acc[32];
#pragma unroll
    for (int p = 0; p < 16; ++p) { acc[2 * p] = acc2[p][0]; acc[2 * p + 1] = acc2[p][1]; }
    LAS float* sm = (LAS float*)lds;
    __syncthreads();
#pragma unroll
    for (int t = 0; t < 32; ++t) sm[t * 512 + c] = acc[t];
    __syncthreads();
#pragma unroll
    for (int tt = 0; tt < 4; ++tt) {
        const int t = wid * 4 + tt;
        float v[8]; float s = 0.f;
#pragma unroll
        for (int k = 0; k < 8; ++k) { v[k] = sm[t * 512 + lane + 64 * k]; s += v[k]; }
        const float mean = wave_sum(s) * (1.f / 512.f);
        float q = 0.f;
#pragma unroll
        for (int k = 0; k < 8; ++k) { v[k] -= mean; q += v[k] * v[k]; }
        const float rstd = __builtin_amdgcn_rsqf(wave_sum(q) * (1.f / 512.f) + 1e-5f);
#pragma unroll
        for (int k = 0; k < 8; ++k) {
            const int cc = lane + 64 * k;
            const float y = v[k] * rstd * lg[cc] + lb[cc];
            O[(size_t)(t0 + t) * DM + cc] = f2bf(silu_f(y));
        }
    }
    __syncthreads();
}

__constant__ float ROPE_INV[16] = {1.f, 0.562341332f, 0.316227764f, 0.177827939f, 0.100000001f, 0.0562341325f, 0.0316227749f, 0.0177827943f,
                                   0.00999999978f, 0.00562341325f, 0.00316227763f, 0.00177827943f, 0.00100000005f, 0.000562341302f, 0.000316227757f, 0.00017782794f};

__device__ __forceinline__ void transpose_item(const float* __restrict__ W, int K, int N, bf16_t* __restrict__ WT, int k0, int n0, int drow0, LAS float* scr, int lane) {
    float wv[32];
    const float* wp = W + (size_t)(k0 + (lane >> 5)) * N + n0 + (lane & 31);
#pragma unroll
    for (int i = 0; i < 32; ++i) wv[i] = wp[(size_t)(2 * i) * N];
#pragma unroll
    for (int i = 0; i < 32; ++i) scr[(2 * i + (lane >> 5)) * 33 + (lane & 31)] = wv[i];
    asm volatile("s_waitcnt lgkmcnt(0)" ::: "memory");
    const int c = lane & 7;
#pragma unroll
    for (int j = 0; j < 4; ++j) {
        const int n = (lane >> 3) + 8 * j; const LAS float* s = scr + (8 * c) * 33 + n;
        u32x4 o; o.x = pk_bf16(s[0 * 33], s[1 * 33]); o.y = pk_bf16(s[2 * 33], s[3 * 33]); o.z = pk_bf16(s[4 * 33], s[5 * 33]); o.w = pk_bf16(s[6 * 33], s[7 * 33]);
        *(u32x4*)(WT + (size_t)(drow0 + n) * K + k0 + 8 * c) = o;
    }
    asm volatile("s_waitcnt lgkmcnt(0)" ::: "memory");
}

__device__ __forceinline__ void prologue(const Args& a, LAS unsigned char* lds) {
    const int tid = otid(), lane = tid & 63, wid = tid >> 6;
    const int gw = blockIdx.x * 8 + wid, NGW = gridDim.x * 8;
    unsigned char* ws = a.ws;
    LAS float* scr = (LAS float*)(lds + wid * 8448);
    constexpr int I_INAB = 16 * 72, I_OUT = 16 * 32, I_INCD = 16 * 80, I_W1 = 16 * 88, I_W2 = 44 * 32;
    constexpr int NITEMS = 2 * (I_INAB + I_OUT + I_INCD + I_OUT) + 8 * I_W1 + 4 * I_W2;
    for (int it = gw; it < NITEMS; it += NGW) {
        int r = it; const float* src; bf16_t* dst; int K = DM, N, nblk, mode, q;
        if (r < 2 * I_INAB) { const int m = r / I_INAB; q = r % I_INAB; N = AB_IN; src = a.in[8] + (size_t)m * DM * AB_IN; dst = (bf16_t*)(ws + WS_WINAB + m * SZ_WINAB); mode = 1; }
        else if ((r -= 2 * I_INAB) < 2 * I_OUT) { const int m = r / I_OUT; q = r % I_OUT; N = DM; src = a.in[12] + (size_t)m * DM * DM; dst = (bf16_t*)(ws + WS_WOUTAB + m * SZ_WOUT); mode = 0; }
        else if ((r -= 2 * I_OUT) < 2 * I_INCD) { const int m = r / I_INCD; q = r % I_INCD; N = CD_IN; src = a.in[13] + (size_t)m * DM * CD_IN; dst = (bf16_t*)(ws + WS_WINCD + m * SZ_WINCD); mode = 1; }
        else if ((r -= 2 * I_INCD) < 2 * I_OUT) { const int m = r / I_OUT; q = r % I_OUT; N = DM; src = a.in[23] + (size_t)m * DM * DM; dst = (bf16_t*)(ws + WS_WOUTCD + m * SZ_WOUT); mode = 0; }
        else if ((r -= 2 * I_OUT) < 4 * I_W1) { const int m = r / I_W1; q = r % I_W1; N = DFF; src = a.in[24] + (size_t)m * DM * DFF; dst = (bf16_t*)(ws + WS_W13 + m * SZ_W13); mode = 2; }
        else if ((r -= 4 * I_W1) < 4 * I_W1) { const int m = r / I_W1; q = r % I_W1; N = DFF; src = a.in[25] + (size_t)m * DM * DFF; dst = (bf16_t*)(ws + WS_W13 + m * SZ_W13); mode = 3; }
        else { r -= 4 * I_W1; const int m = r / I_W2; q = r % I_W2; K = DFF; N = DM; src = a.in[26] + (size_t)m * DFF * DM; dst = (bf16_t*)(ws + WS_W2 + m * SZ_W2); mode = 0; }
        nblk = N / 32;
        const int kb = q / nblk, nb = q % nblk;
        int drow;
        if (mode == 1) { const int pn = nb >> 3, lg = nb & 7; drow = 256 * pn + 32 * (4 * (lg & 1) + (lg >> 1)); }
        else if (mode == 2) drow = 256 * (nb >> 2) + 32 * (nb & 3);
        else if (mode == 3) drow = 256 * (nb >> 2) + 128 + 32 * (nb & 3);
        else drow = 32 * nb;
        transpose_item(src, K, N, dst, 64 * kb, 32 * nb, drow, scr, lane);
    }
    {
        const int g = blockIdx.x * 512 + tid;
        if (g < 64) ((unsigned*)ws)[g] = 0u;
        if (g < 4096) {
            const int pos = g >> 4, i = g & 15;
            const float ang = (float)pos * ROPE_INV[i];
            const double x = (double)ang;
            const double n = rint(x * 0.15915494309189535);
            const float rr = (float)(x - n * 6.283185307179586);
            float* rp = (float*)(ws + WS_ROPE) + g * 2;
            rp[0] = __cosf(rr); rp[1] = __sinf(rr);
        }
    }
    __syncthreads();
    {
        LAS float* cs = (LAS float*)lds;
        LAS float* part = (LAS float*)(lds + 36864);
        bool filled = false;
        for (int u = blockIdx.x; u < 384; u += gridDim.x) {
            if (!filled) {
                for (int i = tid; i < NBATCH * DM; i += 512) { const float v = i < 8 * DM ? a.in[2][i] : a.in[3][i - 8 * DM]; cs[i] = silu_f(v); }
                filled = true;
            }
            __syncthreads();
            const int li = u / 96, n0 = (u % 96) * 64;
            const float* wp = a.in[4] + (size_t)li * DM * 6144 + (size_t)(wid * 128) * 6144 + n0 + lane;
            float acc[NBATCH];
#pragma unroll
            for (int bb = 0; bb < NBATCH; ++bb) acc[bb] = 0.f;
#pragma unroll 8
            for (int k = 0; k < 128; ++k) {
                const float wv = wp[(size_t)k * 6144];
#pragma unroll
                for (int bb = 0; bb < NBATCH; ++bb) acc[bb] = fmaf(cs[bb * DM + wid * 128 + k], wv, acc[bb]);
            }
#pragma unroll
            for (int bb = 0; bb < NBATCH; ++bb) part[(wid * NBATCH + bb) * 64 + lane] = acc[bb];
            __syncthreads();
            for (int i = tid; i < NBATCH * 64; i += 512) {
                const int bb = i >> 6, l = i & 63;
                float s = a.in[5][li * 6144 + n0 + l];
#pragma unroll
                for (int w8 = 0; w8 < 8; ++w8) s += part[(w8 * NBATCH + bb) * 64 + l];
                ((float*)(ws + WS_MOD))[((size_t)li * NBATCH + bb) * 6144 + n0 + l] = s;
            }
        }
    }
}

template <bool F32IN>
__device__ __forceinline__ void norm_phase(const float* xp, const float* xs, const bf16_t* xb, bf16_t* H, const float* g, const float* modl  , int shift_chunk) {
    const int tid = otid(), lane = tid & 63, wid = tid >> 6;
    const int gw = blockIdx.x * 8 + wid, NGW = gridDim.x * 8;
    for (int ch = gw; ch < T_ALL / 8; ch += NGW) {
        const int row0 = ch * 8, b = batch_of(row0);
        const float* sh = modl + b * 6144 + shift_chunk * DM; const float* sc = sh + DM;
        f32x4 mul[4], add[4];
#pragma unroll
        for (int j = 0; j < 4; ++j) {
            const int c = 4 * lane + 256 * j;
            mul[j] = *(const f32x4*)(g + c) * (*(const f32x4*)(sc + c) + 1.f); add[j] = *(const f32x4*)(sh + c);
        }
        const float* xr0 = row0 < T_PROMPT ? xp + (size_t)row0 * DM : xs + (size_t)(row0 - T_PROMPT) * DM;
#pragma unroll 1
        for (int r4 = 0; r4 < 8; r4 += 4) {
            f32x4 v[4][4];
#pragma unroll
            for (int rr = 0; rr < 4; ++rr)
#pragma unroll
                for (int j = 0; j < 4; ++j) {
                    if constexpr (F32IN) v[rr][j] = *(const f32x4*)(xr0 + (size_t)(r4 + rr) * DM + 4 * lane + 256 * j);
                    else { const u32x2 w = *(const u32x2*)(xb + (size_t)(row0 + r4 + rr) * DM + 4 * lane + 256 * j);
                           v[rr][j] = (f32x4){__uint_as_float(w.x << 16), __uint_as_float(w.x & 0xffff0000u), __uint_as_float(w.y << 16), __uint_as_float(w.y & 0xffff0000u)}; }
                }
#pragma unroll
            for (int rr = 0; rr < 4; ++rr) {
                float s = 0.f;
#pragma unroll
                for (int j = 0; j < 4; ++j) s += (v[rr][j][0] * v[rr][j][0] + v[rr][j][1] * v[rr][j][1]) + (v[rr][j][2] * v[rr][j][2] + v[rr][j][3] * v[rr][j][3]);
                const float rstd = __builtin_amdgcn_rsqf(wave_sum(s) * (1.f / DM) + 1e-6f);
#pragma unroll
                for (int j = 0; j < 4; ++j) {
                    const f32x4 y = v[rr][j] * rstd * mul[j] + add[j];
                    u32x2 w; w.x = pk_bf16(y[0], y[1]); w.y = pk_bf16(y[2], y[3]);
                    *(u32x2*)(H + (size_t)(row0 + r4 + rr) * DM + 4 * lane + 256 * j) = w;
                }
            }
        }
    }
}
__device__ __forceinline__ void final_norm_pass1(const bf16_t* xb, bf16_t* H, float* out, const float* g, int rowlim) {
    const int tid = otid(), lane = tid & 63, wid = tid >> 6;
    const int gw = blockIdx.x * 8 + wid, NGW = gridDim.x * 8;
    f32x4 mul[4];
#pragma unroll
    for (int j = 0; j < 4; ++j) mul[j] = *(const f32x4*)(g + 4 * lane + 256 * j);
    for (int row0 = gw * 4; row0 < T_ALL; row0 += NGW * 4) {
        f32x4 v[4][4];
#pragma unroll
        for (int rr = 0; rr < 4; ++rr)
#pragma unroll
            for (int j = 0; j < 4; ++j) { const u32x2 w = *(const u32x2*)(xb + (size_t)(row0 + rr) * DM + 4 * lane + 256 * j);
                v[rr][j] = (f32x4){__uint_as_float(w.x << 16), __uint_as_float(w.x & 0xffff0000u), __uint_as_float(w.y << 16), __uint_as_float(w.y & 0xffff0000u)}; }
#pragma unroll
        for (int rr = 0; rr < 4; ++rr) {
            float s = 0.f;
#pragma unroll
            for (int j = 0; j < 4; ++j) s += (v[rr][j][0] * v[rr][j][0] + v[rr][j][1] * v[rr][j][1]) + (v[rr][j][2] * v[rr][j][2] + v[rr][j][3] * v[rr][j][3]);
            const float rstd = __builtin_amdgcn_rsqf(wave_sum(s) * (1.f / DM) + 1e-6f);
            if (row0 < rowlim) {
#pragma unroll
                for (int j = 0; j < 4; ++j) *(f32x4*)(out + (size_t)(row0 + rr) * DM + 4 * lane + 256 * j) = v[rr][j] * rstd * mul[j];
            } else {
#pragma unroll
                for (int j = 0; j < 4; ++j) { const f32x4 y = v[rr][j] * rstd * mul[j]; u32x2 w; w.x = pk_bf16(y[0], y[1]); w.y = pk_bf16(y[2], y[3]);
                    *(u32x2*)(H + (size_t)(row0 + rr) * DM + 4 * lane + 256 * j) = w; }
            }
        }
    }
}
__device__ __forceinline__ void final_norm_pass2(const bf16_t* H, float* out, int k2) {
    const int tid = otid();
    const size_t gt = (size_t)blockIdx.x * 512 + tid, GT = (size_t)gridDim.x * 512;
    for (size_t i = (size_t)T_ALL * DM / 16 * (size_t)k2 + gt; i < (size_t)T_ALL * DM / 8; i += GT) {
        const u32x4 w = *(const u32x4*)(H + i * 8);
        const f32x4 a = {__uint_as_float(w.x << 16), __uint_as_float(w.x & 0xffff0000u), __uint_as_float(w.y << 16), __uint_as_float(w.y & 0xffff0000u)};
        const f32x4 b = {__uint_as_float(w.z << 16), __uint_as_float(w.z & 0xffff0000u), __uint_as_float(w.w << 16), __uint_as_float(w.w & 0xffff0000u)};
        *(f32x4*)(out + i * 8) = a; *(f32x4*)(out + i * 8 + 4) = b;
    }
}

#define XB_TMO      128
#define XB_XCNT(j)  (256  + 64 * (j))
#define XB_XSUB(j)  (1280 + 64 * (j))
#define XB_XGEN(j)  (2304 + 64 * (j))
#define XB_TOP      3328
#define XB_TOPGEN   3392
#define XCD_BAR_WORDS 3456
#define XB_SPIN_CAP (1u << 18)

__device__ __forceinline__ unsigned xb_ld(unsigned* p)              { return __hip_atomic_load(p, __ATOMIC_RELAXED, __HIP_MEMORY_SCOPE_AGENT); }
__device__ __forceinline__ unsigned xb_add(unsigned* p, unsigned v) { return __hip_atomic_fetch_add(p, v, __ATOMIC_RELAXED, __HIP_MEMORY_SCOPE_AGENT); }
__device__ __forceinline__ unsigned xb_xcc_id() { return (unsigned)__builtin_amdgcn_s_getreg((3 << 11) | 20) & 0xFu; }
#define XB_SPIN(cond, bar) do { unsigned _sp = 0; while (cond) { __builtin_amdgcn_s_sleep(1); \
    if ((++_sp & 255u) == 0u) { if (xb_ld(&(bar)[XB_TMO])) break; if (_sp > XB_SPIN_CAP) { atomicAdd(&(bar)[XB_TMO], 1u); break; } } } } while (0)

struct XcdBarrier {
    unsigned* bar; unsigned x;
    volatile LAS unsigned* st;
};

__device__ __forceinline__ XcdBarrier xcd_barrier_post(unsigned* bar, volatile LAS unsigned* st) {
    XcdBarrier b; b.bar = bar; b.x = xb_xcc_id(); b.st = st;
    if (threadIdx.x == 0) (void)xb_add(&bar[XB_XCNT(b.x)], 1u);
    return b;
}
__device__ __forceinline__ void xcd_barrier_complete(unsigned* bar, unsigned x, unsigned& nloc, unsigned& nx) {
    const unsigned G = gridDim.x * gridDim.y * gridDim.z;
    unsigned sum, cnt, mine, sp = 0u;
    for (;;) {
        sum = 0u; cnt = 0u; mine = 0u;
#pragma unroll
        for (unsigned j = 0; j < 16; ++j) { const unsigned c = xb_ld(&bar[XB_XCNT(j)]); sum += c; cnt += (c > 0u) ? 1u : 0u; mine = (j == x) ? c : mine; }
        if (sum == G) break;
        __builtin_amdgcn_s_sleep(1);
        if ((++sp & 255u) == 0u) { if (xb_ld(&bar[XB_TMO])) break; if (sp > XB_SPIN_CAP) { atomicAdd(&bar[XB_TMO], 1u); break; } }
    }
    nloc = mine > 0u ? mine : 1u; nx = cnt > 0u ? cnt : 1u;
}

__device__ __forceinline__ void xcd_barrier(const XcdBarrier& b) {
    asm volatile("s_waitcnt vmcnt(0)" ::: "memory");
    __syncthreads();
    if (threadIdx.x == 0) {
        unsigned* bar = b.bar;
        __builtin_amdgcn_s_waitcnt(0);
        unsigned nloc = b.st[0], nx = b.st[1];
        if (nloc == 0u) { xcd_barrier_complete(bar, b.x, nloc, nx); b.st[0] = nloc; b.st[1] = nx; }
        const unsigned old = xb_add(&bar[XB_XSUB(b.x)], 1u);
        const unsigned gen = old / nloc;
        if (old + 1u == (gen + 1u) * nloc) {
            __builtin_amdgcn_fence(__ATOMIC_RELEASE, "agent");
            asm volatile("s_waitcnt vmcnt(0)" ::: "memory");
            const unsigned og = xb_add(&bar[XB_TOP], 1u);
            const unsigned tg = og / nx;
            if (og + 1u == (tg + 1u) * nx) xb_add(&bar[XB_TOPGEN], 1u);
            else XB_SPIN(xb_ld(&bar[XB_TOPGEN]) == tg, bar);
            __builtin_amdgcn_fence(__ATOMIC_ACQUIRE, "agent");
            xb_add(&bar[XB_XGEN(b.x)], 1u);
            asm volatile("s_waitcnt vmcnt(0)" ::: "memory");
        } else {
            XB_SPIN(xb_ld(&bar[XB_XGEN(b.x)]) == gen, bar);
            __builtin_amdgcn_fence(__ATOMIC_ACQUIRE, "agent");
            asm volatile("s_waitcnt vmcnt(0)" ::: "memory");
        }
    }
    __syncthreads();
}

#ifndef PROBE_PH
#define PROBE_PH -1
#define PROBE_PH2 -1
#endif
#ifndef PROBE_REP
#define PROBE_REP 0
#define PROBE_LI 0
#endif
#ifndef ONLY
#define ONLY 0
#endif
#define EN(k) (ONLY == 0 || ONLY == (k))
__global__ void __launch_bounds__(512) mega_fwd(Args a) {
    extern __shared__ __attribute__((aligned(16))) unsigned char lds_raw[];
    LAS unsigned char* lds = (LAS unsigned char*)lds_raw;
    cg::grid_group grid = cg::this_grid();
    unsigned char* ws = a.ws;
    float* mod = (float*)(ws + WS_MOD);
    bf16_t* H = (bf16_t*)(ws + WS_H);
    bf16_t* Zb = (bf16_t*)(ws + WS_Z);
    float* xout = a.out;
    bf16_t* xb = (bf16_t*)(a.out + (size_t)T_ALL * DM / 2);
    volatile LAS unsigned* bst = (volatile LAS unsigned*)(lds + 131072 + 64);
    if (otid() < 2) bst[otid()] = 0u;
    __syncthreads();
#ifdef PROBE_NSYNC
    for (int i_ = 0; i_ < PROBE_NSYNC; ++i_) xcd_barrier(xbar);
#endif
    if (blockIdx.x == 0) { for (int i = otid(); i < 4096; i += 512) ((unsigned*)(ws + WS_BAR))[i] = 0u; }
    if (EN(1)) prologue(a, lds);
    grid.sync();
    XcdBarrier xbar = xcd_barrier_post((unsigned*)(ws + WS_BAR), bst);
    for (int ph_ = 1; ph_ < a.ph_hi; ++ph_) {
        if (ph_ > 1) xcd_barrier(xbar);
#if PROBE_PH >= 0
        const int ph = ph_ - (ph_ > PROBE_PH ? 1 : 0) - ((PROBE_PH2 >= 0 && ph_ > PROBE_PH2 + 1) ? 1 : 0);
#else
        const int ph = ph_;
#endif
        {
        if (ph == 0) { if (EN(1)) prologue(a, lds); }
        else
        if (ph == NPHASE - 2) { if (EN(2)) final_norm_pass1(H, H, xout, a.in[27], (a.ph_hi - NPHASE + 1) * T_ALL); }
        else if (ph == NPHASE - 1) { if (EN(2)) final_norm_pass2(H, xout, a.ph_hi - NPHASE + 2); }
        else {
        const int li = (ph - 1) / 7, sub = (ph - 1) % 7, j = li >> 1;
        const bool cd = (li & 1) != 0;
        const float* modl = mod + (size_t)li * NBATCH * 6144;
        if (sub == 0 || sub == 4) {
            if (li == 0 && sub == 0) { if (EN(2)) norm_phase<true>(a.in[0], a.in[1], xb, H, a.in[6] + li * DM, modl, 0); }
            else { if (EN(2)) norm_phase<false>(nullptr, nullptr, xb, H, (sub == 0 ? a.in[6] : a.in[7]) + li * DM, modl, sub == 0 ? 0 : 3); }
        } else if (sub == 1) {
            pg8::StaticOrder S;
            if (!cd) {
                pg8::Gemm g{H, (const bf16_t*)(ws + WS_WINAB + j * SZ_WINAB), T_ALL, AB_IN, DM}; S.init(T_ALL, AB_IN, gridDim.x, blockIdx.x);
                EpiInAB E{Zb, a.in[10] + j * 64, a.in[11] + j * 64, (const float*)(ws + WS_ROPE)};
                if (EN(3)) pg8::gemm_phase<EpiInAB, pg8::StaticOrder, true, true>(lds, g, S, E);
            } else {
                pg8::Gemm g{H, (const bf16_t*)(ws + WS_WINCD + j * SZ_WINCD), T_ALL, CD_IN, DM}; S.init(T_ALL, CD_IN, gridDim.x, blockIdx.x);
                EpiInCD E{Zb, (unsigned*)ws + 16 * j};
                if (EN(4)) pg8::gemm_phase<EpiInCD, pg8::StaticOrder, true, true>(lds, g, S, E);
            }
        } else if (sub == 2) {
#if PROBE_REP
          for (int rep_ = 0; rep_ < ((li == PROBE_LI) ? 2 : 1); ++rep_) {
            if (rep_) grid.sync();
#else
          {
#endif
            if (!cd) {
                const float* rpb = a.in[9] + (size_t)j * 8 * 465;
                if (EN(5)) for (int u = blockIdx.x; u < 3072; u += gridDim.x) {
                    if (u < 512) gqa_unit(lds, Zb, H, a.in[10] + j * 64, a.in[11] + j * 64, 8, u >> 6, u & 63);
                    else if (u < 1536) { const int v = u - 512; gqa_unit(lds, Zb, H, a.in[10] + j * 64, a.in[11] + j * 64, v >> 7, (v >> 4) & 7, v & 15); }
                    else if (u < 2048) { const int v = u - 1536; na_unit(lds, Zb, H, rpb, 8, v >> 6, v & 63);
#ifdef PROBE_NA2
                        if (li == 0) na_unit(lds, Zb, H, rpb, 8, v >> 6, v & 63);
#endif
                    }
                    else { const int v = u - 2048; na_unit(lds, Zb, H, rpb, v >> 7, (v >> 4) & 7, v & 15);
#ifdef PROBE_NA2
                        if (li == 0) na_unit(lds, Zb, H, rpb, v >> 7, (v >> 4) & 7, v & 15);
#endif
                    }
                }
            } else {
                const unsigned* nrm = (const unsigned*)ws + 16 * j;
                int* ctr = (int*)ws + 32 + ph_;
                LAS int* uw = (LAS int*)(lds + 131072);
                if (EN(6) || ONLY == 9) for (;;) {
                    __syncthreads();
                    if (otid() == 0) *uw = atomicAdd(ctr, 1);
                    __syncthreads();
                    const int u = __builtin_amdgcn_readfirstlane(*uw);
                    if (u >= 3072) break;
                    if (u < 1536) {
                        int b, h, qb;
                        if (u < 128) { b = 8; h = 3; qb = u; }
                        else if (u < 256) { b = 8; h = 2; qb = u - 128; }
                        else if (u < 768) { const int v = u - 256; h = 3 - (v >> 8); b = (v >> 5) & 7; qb = v & 31; }
                        else if (u < 896) { b = 8; h = 1; qb = u - 768; }
                        else if (u < 1152) { const int v = u - 896; h = 1; b = v >> 5; qb = v & 31; }
                        else if (u < 1280) { b = 8; h = 0; qb = u - 1152; }
                        else { const int v = u - 1280; h = 0; b = v >> 5; qb = v & 31; }
                        if (ONLY != 9) diff_unit(lds, Zb, H, a.in[18] + j * 64, a.in[19] + j * 64, a.in[20] + j * 64, a.in[21] + j * 64, a.in[22] + j * 128, li, nrm, b, h, qb);
                    } else if (ONLY != 6) conv_unit(lds, Zb, H, a.in[14] + (size_t)j * 31 * 512, a.in[15] + j * 512, a.in[16] + j * 512, a.in[17] + j * 512, u - 1536);
                }
            }
          }
        } else if (sub == 3 || sub == 6) {
            pg8::StaticOrder S; S.init(T_ALL, DM, gridDim.x, blockIdx.x);
            pg8::Gemm g;
            if (sub == 3) g = pg8::Gemm{H, (const bf16_t*)(ws + (cd ? WS_WOUTCD : WS_WOUTAB) + j * SZ_WOUT), T_ALL, DM, DM};
            else g = pg8::Gemm{Zb, (const bf16_t*)(ws + WS_W2 + li * SZ_W2), T_ALL, DM, DFF};
            const bool first = (li == 0 && sub == 3);
            if (first) {
                EpiRes<true> E{a.in[0], a.in[1], xb, modl + (sub == 3 ? 2 : 5) * DM, (PROBE_PH >= 0 && ph_ == PROBE_PH + 1) ? Zb : xb};
                if (EN(7)) pg8::gemm_phase<EpiRes<true>, pg8::StaticOrder, true, true>(lds, g, S, E);
            } else {
                EpiRes<false> E{nullptr, nullptr, xb, modl + (sub == 3 ? 2 : 5) * DM, (sub == 6 && li == 3) ? H : xb};
                if (EN(7)) pg8::gemm_phase<EpiRes<false>, pg8::StaticOrder, true, true>(lds, g, S, E);
            }
        } else {
            pg8::StaticOrder S; S.init(T_ALL, 2 * DFF, gridDim.x, blockIdx.x);
            pg8::Gemm g{H, (const bf16_t*)(ws + WS_W13 + li * SZ_W13), T_ALL, 2 * DFF, DM};
            EpiUp E{Zb};
            if (EN(8)) pg8::gemm_phase<EpiUp, pg8::StaticOrder, true, true>(lds, g, S, E);
        }
        }
        }
    }
}

#ifndef MK_SINGLE
#define MK_SINGLE 1
#endif
extern "C" void kernel_launch(void* const* d_in, const int* in_sizes, int n_in, void* d_out, int out_size, void* d_ws, size_t ws_size, hipStream_t stream) {
    static int grid = 0;
    if (grid == 0) {
        if (n_in != 28 || out_size != T_ALL * DM || ws_size < WS_NEED) { fprintf(stderr, "kernel_launch: unexpected shapes (n_in %d out %d ws %zu)\n", n_in, out_size, ws_size); grid = -1; return; }
        int dev = 0, cus = 0, per_cu = 0;
        hipGetDevice(&dev); hipDeviceGetAttribute(&cus, hipDeviceAttributeMultiprocessorCount, dev);
        hipFuncSetAttribute((const void*)mega_fwd, hipFuncAttributeMaxDynamicSharedMemorySize, LDS_BYTES);
        hipOccupancyMaxActiveBlocksPerMultiprocessor(&per_cu, (const void*)mega_fwd, 512, LDS_BYTES);
        if (per_cu < 1) { fprintf(stderr, "kernel_launch: occupancy query says %d blocks per CU\n", per_cu); per_cu = 1; }
        (void)hipGetLastError();
        grid = cus * 1;
    }
    if (grid < 0) return;
    Args a{};
    for (int i = 0; i < 28; ++i) a.in[i] = (const float*)d_in[i];
    a.out = (float*)d_out; a.ws = (unsigned char*)d_ws;
#if MK_SINGLE
    a.ph_lo = 0; a.ph_hi = NPHASE + (PROBE_PH >= 0 ? 1 : 0) + (PROBE_PH2 >= 0 ? 1 : 0);
    void* args[] = {&a};
    hipError_t e = hipLaunchCooperativeKernel((const void*)mega_fwd, dim3(grid), dim3(512), args, LDS_BYTES, stream);
    if (e != hipSuccess) fprintf(stderr, "cooperative launch failed: %s (grid %d)\n", hipGetErrorString(e), grid);
#else
    for (int ph = 0; ph < NPHASE; ++ph) {
        a.ph_lo = ph; a.ph_hi = ph + 1;
        hipLaunchKernelGGL(mega_fwd, dim3(grid), dim3(512), LDS_BYTES, stream, a);
    }
#endif
}
```

```cpp
#include <hip/hip_runtime.h>
#include <hip/hip_cooperative_groups.h>
#include <cstdio>
#include <cstdint>
namespace cg = cooperative_groups;
namespace pg8 {
#define PG8_LAS __attribute__((address_space(3)))
typedef unsigned short bf16_t;
typedef short bf16x8 __attribute__((ext_vector_type(8)));
typedef float f32x4 __attribute__((ext_vector_type(4)));
typedef unsigned u32x4 __attribute__((ext_vector_type(4)));
constexpr int BM = 256, BK = 64, HALF = 128, HTB = HALF * BK * 2  , STAGE_BYTES = 8 * HTB, NXCD = 8, WGM = 8;

__host__ __device__ __forceinline__ int lds_byte(int r, int c) { const int st = (r >> 4) * 2 + (c >> 5), rr = r & 15, cc = c & 31, ob = rr * 64 + cc * 2; return st * 1024 + (ob ^ (((ob >> 9) & 1) << 5)); }
__host__ __device__ __forceinline__ void stage_rc(int b, int& R, int& C) { const int st = b / 1024, sb = b % 1024, swz = sb ^ (((sb >> 9) & 1) << 5); R = (st >> 1) * 16 + swz / 64; C = (st & 1) * 32 + (swz % 64) / 2; }
__host__ __device__ __forceinline__ int perm32(int rho) { const int n = rho >> 4, i = rho & 15; return 8 * (i >> 2) + 4 * n + (i & 3); }

struct Unit { int pm, pn; };
struct Gemm { const bf16_t* A; const bf16_t* Bt; int M, N, K; };

struct StaticOrder {
    int nM, nN, nwg, G, c;
    __host__ __device__ void init(int M, int N, int G_, int c_) { nM = M / BM; nN = N / BM; nwg = nM * nN; G = G_; c = c_; }
    __host__ __device__ bool next(int i, Unit& u) const {
        const long L = (long)i * G + c; if (L >= nwg) return false;
        int wgid = (int)L; { const int q = nwg / NXCD, r = nwg % NXCD, xcd = wgid % NXCD, off = wgid / NXCD; wgid = (xcd < r ? xcd * (q + 1) : r * (q + 1) + (xcd - r) * q) + off; }
        const int nig = WGM * nN, gid = wgid / nig, fm = gid * WGM, gsz = (nM - fm) < WGM ? (nM - fm) : WGM;
        u.pm = fm + ((wgid % nig) % gsz); u.pn = (wgid % nig) / gsz; return true;
    }
    __device__ __forceinline__ void a_ready(const Unit&) const {}
    __device__ __forceinline__ void done(const Unit&) const {}
};

__device__ __forceinline__ unsigned cvt_pk_bf16(float lo, float hi) { unsigned r; asm volatile("v_cvt_pk_bf16_f32 %0, %1, %2" : "=v"(r) : "v"(lo), "v"(hi)); return r; }
typedef float f32x2 __attribute__((ext_vector_type(2)));
template <class Epi, class Sched, bool ALIGN_EPI = false, bool SP2 = false>
__device__ __forceinline__ void gemm_phase(PG8_LAS unsigned char* lds, const Gemm g, const Sched& S, const Epi& E) {
    int tid_ = threadIdx.x; asm volatile("" : "+v"(tid_)); const int tid = tid_, wid = __builtin_amdgcn_readfirstlane(tid >> 6), lane = tid & 63, wr = wid >> 2, wc = wid & 3, fr = lane & 15, fq = lane >> 4;
    const int K = g.K, nt = K / BK;
    unsigned voffA[2], voffB[2];
#pragma unroll
    for (int i = 0; i < 2; ++i) { int R, C; stage_rc(tid * 16 + i * 8192, R, C); const int Rb = Epi::PERM ? ((R & ~31) + perm32(R & 31)) : R;
        voffA[i] = (unsigned)(R * K + C) * 2u; voffB[i] = (unsigned)(Rb * K + C) * 2u; }
    const size_t kstep = (size_t)(BK * 2);
    const size_t hstep = (size_t)HALF * K * 2;
    const size_t tstep = 2 * hstep;
    const unsigned ldsw = (unsigned)wid * 1024u;
    const int aoff = lds_byte(wr * 64 + fr, fq * 8), boff = lds_byte(wc * 32 + fr, fq * 8);
#define PG8_SA(b, h) (((b) * 2 + (h)) * HTB)
#define PG8_SB(b, h) ((4 + (b) * 2 + (h)) * HTB)
#define PG8_STAGE(bufoff, gbase, voff) do { _Pragma("unroll") for (int _i = 0; _i < 2; ++_i) \
        __builtin_amdgcn_global_load_lds((const unsigned*)((const char*)(gbase) + (voff)[_i]), (PG8_LAS unsigned*)(lds + (bufoff) + ldsw + _i * 8192), 16, 0, 0); } while (0)
#define PG8_LDA(dst, b, h) do { _Pragma("unroll") for (int m = 0; m < 4; ++m) _Pragma("unroll") for (int k = 0; k < 2; ++k) dst[m][k] = *(const PG8_LAS bf16x8*)(lds + PG8_SA(b, h) + aoff + m * 2048 + k * 1024); } while (0)
#define PG8_LDB(dst, b, h) do { _Pragma("unroll") for (int n = 0; n < 2; ++n) _Pragma("unroll") for (int k = 0; k < 2; ++k) dst[n][k] = *(const PG8_LAS bf16x8*)(lds + PG8_SB(b, h) + boff + n * 2048 + k * 1024); } while (0)
#define PG8_MMA(ai, bj, At, Bt) do { __builtin_amdgcn_s_setprio(1); _Pragma("unroll") for (int m = 0; m < 4; ++m) _Pragma("unroll") for (int n = 0; n < 2; ++n) _Pragma("unroll") for (int k = 0; k < 2; ++k) \
        acc[ai][bj][m][n] = __builtin_amdgcn_mfma_f32_16x16x32_bf16(Bt[n][k], At[m][k], acc[ai][bj][m][n], 0, 0, 0); __builtin_amdgcn_s_setprio(0); } while (0)
#define PG8_WAIT_V(n) asm volatile("s_waitcnt vmcnt(" #n ")" ::: "memory")
#define PG8_WAIT_L(n) asm volatile("s_waitcnt lgkmcnt(" #n ")" ::: "memory")
#define PG8_BAR __builtin_amdgcn_s_barrier()
#define PG8_SCHED __builtin_amdgcn_sched_barrier(0)
    Unit cur, nxt; int ui = 0;
    if (!S.next(0, cur)) return;
    f32x4 acc[2][2][4][2];
#pragma unroll
    for (int a = 0; a < 2; ++a)
#pragma unroll
        for (int b = 0; b < 2; ++b)
#pragma unroll
            for (int m = 0; m < 4; ++m)
#pragma unroll
                for (int n = 0; n < 2; ++n) acc[a][b][m][n] = (f32x4){0.f, 0.f, 0.f, 0.f};
    bf16x8 At[4][2], B0[2][2], B1[2][2];
    const char* cA = (const char*)g.A + (size_t)cur.pm * tstep; const char* cB = (const char*)g.Bt + (size_t)cur.pn * tstep;
    S.a_ready(cur);
    if constexpr (SP2) {
        PG8_STAGE(PG8_SB(0, 0), cB, voffB); PG8_STAGE(PG8_SB(0, 1), cB + hstep, voffB); PG8_STAGE(PG8_SA(0, 0), cA, voffA); PG8_STAGE(PG8_SA(0, 1), cA + hstep, voffA);
        if (wr == 1) PG8_BAR;
        PG8_WAIT_V(2); PG8_BAR;
        PG8_STAGE(PG8_SB(1, 0), cB + kstep, voffB); PG8_STAGE(PG8_SA(1, 0), cA + kstep, voffA); PG8_STAGE(PG8_SB(1, 1), cB + hstep + kstep, voffB);
        PG8_WAIT_V(6); PG8_BAR;
    } else {
        PG8_STAGE(PG8_SB(0, 0), cB, voffB); PG8_STAGE(PG8_SA(0, 0), cA, voffA); PG8_STAGE(PG8_SB(0, 1), cB + hstep, voffB); PG8_STAGE(PG8_SA(0, 1), cA + hstep, voffA);
        if (wr == 1) PG8_BAR;
        PG8_WAIT_V(4); PG8_BAR;
        PG8_STAGE(PG8_SB(1, 0), cB + kstep, voffB); PG8_STAGE(PG8_SA(1, 0), cA + kstep, voffA); PG8_STAGE(PG8_SB(1, 1), cB + hstep + kstep, voffB);
        PG8_WAIT_V(6); PG8_BAR;
    }
    for (;;) {
        const bool has_next = S.next(ui + 1, nxt);
        const char* nA = has_next ? (const char*)g.A + (size_t)nxt.pm * tstep : cA; const char* nB = has_next ? (const char*)g.Bt + (size_t)nxt.pn * tstep : cB;
        for (int t = 0; t < nt; t += 2) {
            const bool last = (t == nt - 2);
            const char* a1 = cA + (size_t)(t + 1) * kstep;
            const char* a2 = last ? nA : cA + (size_t)(t + 2) * kstep; const char* b2 = last ? nB : cB + (size_t)(t + 2) * kstep;
            const char* a3 = a2 + kstep; const char* b3 = b2 + kstep;
            if (last && has_next) S.a_ready(nxt);
            if constexpr (SP2) {
            PG8_LDB(B0, 0, 0); PG8_LDB(B1, 0, 1); PG8_SCHED; PG8_LDA(At, 0, 0); PG8_STAGE(PG8_SA(1, 1), a1 + hstep, voffA);
            PG8_WAIT_V(8); PG8_WAIT_L(0); PG8_BAR; PG8_MMA(0, 0, At, B0); PG8_MMA(0, 1, At, B1); PG8_BAR; PG8_SCHED;
            PG8_LDA(At, 0, 1); PG8_STAGE(PG8_SB(0, 0), b2, voffB); PG8_STAGE(PG8_SB(0, 1), b2 + hstep, voffB); PG8_STAGE(PG8_SA(0, 0), a2, voffA);
            PG8_WAIT_V(8); PG8_WAIT_L(0); PG8_BAR; PG8_MMA(1, 0, At, B0); PG8_MMA(1, 1, At, B1); PG8_BAR; PG8_SCHED;
            PG8_LDB(B0, 1, 0); PG8_LDB(B1, 1, 1); PG8_SCHED; PG8_LDA(At, 1, 0); PG8_STAGE(PG8_SA(0, 1), a2 + hstep, voffA);
            PG8_WAIT_V(8); PG8_WAIT_L(0); PG8_BAR; PG8_MMA(0, 0, At, B0); PG8_MMA(0, 1, At, B1); PG8_BAR; PG8_SCHED;
            PG8_LDA(At, 1, 1); PG8_STAGE(PG8_SB(1, 0), b3, voffB); PG8_STAGE(PG8_SB(1, 1), b3 + hstep, voffB); PG8_STAGE(PG8_SA(1, 0), a3, voffA);
            PG8_WAIT_V(8); PG8_WAIT_L(0); PG8_BAR; PG8_MMA(1, 0, At, B0); PG8_MMA(1, 1, At, B1); PG8_BAR; PG8_SCHED;
            } else {
            PG8_LDB(B0, 0, 0); PG8_SCHED; PG8_LDA(At, 0, 0); PG8_STAGE(PG8_SA(1, 1), a1 + hstep, voffA);
            PG8_WAIT_L(8); PG8_BAR; PG8_WAIT_L(0); PG8_MMA(0, 0, At, B0); PG8_BAR; PG8_SCHED;
            PG8_LDB(B1, 0, 1); PG8_STAGE(PG8_SB(0, 0), b2, voffB);
            PG8_BAR; PG8_WAIT_L(0); PG8_MMA(0, 1, At, B1); PG8_BAR;
            PG8_LDA(At, 0, 1); PG8_STAGE(PG8_SA(0, 0), a2, voffA);
            PG8_BAR; PG8_WAIT_L(0); PG8_MMA(1, 0, At, B0); PG8_BAR; PG8_SCHED;
            PG8_STAGE(PG8_SB(0, 1), b2 + hstep, voffB);
            PG8_WAIT_V(6); PG8_BAR; PG8_MMA(1, 1, At, B1); PG8_BAR;
            PG8_LDB(B0, 1, 0); PG8_SCHED; PG8_LDA(At, 1, 0); PG8_STAGE(PG8_SA(0, 1), a2 + hstep, voffA);
            PG8_WAIT_L(8); PG8_BAR; PG8_WAIT_L(0); PG8_MMA(0, 0, At, B0); PG8_BAR; PG8_SCHED;
            PG8_LDB(B1, 1, 1); PG8_STAGE(PG8_SB(1, 0), b3, voffB);
            PG8_BAR; PG8_WAIT_L(0); PG8_MMA(0, 1, At, B1); PG8_BAR;
            PG8_LDA(At, 1, 1); PG8_STAGE(PG8_SA(1, 0), a3, voffA);
            PG8_BAR; PG8_WAIT_L(0); PG8_MMA(1, 0, At, B0); PG8_BAR; PG8_SCHED;
            PG8_STAGE(PG8_SB(1, 1), b3 + hstep, voffB);
            PG8_WAIT_V(6); PG8_BAR; PG8_MMA(1, 1, At, B1); PG8_BAR;
            }
        }
        if constexpr (ALIGN_EPI) { if (wr == 0) PG8_BAR; }
        if constexpr (!Epi::AFTER_DRAIN) { E(acc, cur, wr, wc, fr, fq); S.done(cur); }
        if (!has_next) break;
#pragma unroll
        for (int a = 0; a < 2; ++a)
#pragma unroll
            for (int b = 0; b < 2; ++b)
#pragma unroll
                for (int m = 0; m < 4; ++m)
#pragma unroll
                    for (int n = 0; n < 2; ++n) acc[a][b][m][n] = (f32x4){0.f, 0.f, 0.f, 0.f};
        cur = nxt; cA = nA; cB = nB; ++ui;
        if constexpr (ALIGN_EPI) { if (wr == 1) PG8_BAR; }
    }
    PG8_WAIT_V(0);
    if constexpr (!ALIGN_EPI) { if (wr == 0) PG8_BAR; }
    PG8_BAR;
    if constexpr (Epi::AFTER_DRAIN) { E.fused(acc, cur, wr, wc, fr, fq, lds, wid, lane); S.done(cur); }
#undef PG8_SA
#undef PG8_SB
#undef PG8_STAGE
#undef PG8_LDA
#undef PG8_LDB
#undef PG8_MMA
#undef PG8_WAIT_V
#undef PG8_WAIT_L
#undef PG8_BAR
#undef PG8_SCHED
}
}

#ifdef TA
constexpr bool defined_TA = true;
#else
constexpr bool defined_TA = false;
#endif
#ifdef TB
constexpr bool defined_TB = true;
#else
constexpr bool defined_TB = false;
#endif
#define LAS __attribute__((address_space(3)))
typedef unsigned short bf16_t;
typedef short bf16x8 __attribute__((ext_vector_type(8)));
typedef short s16x4 __attribute__((ext_vector_type(4)));
typedef float f32x4 __attribute__((ext_vector_type(4)));
typedef float f32x16 __attribute__((ext_vector_type(16)));
typedef unsigned u32x4 __attribute__((ext_vector_type(4)));
typedef unsigned u32x2 __attribute__((ext_vector_type(2)));
using pg8::Unit;

constexpr int T_ALL = 49152, T_PROMPT = 32768, L_P = 4096, L_S = 16384, DM = 1024, DFF = 2816, NBATCH = 9;
constexpr int AB_IN = 2304, CD_IN = 2560;
constexpr float C2 = 0.18033688011112042f;
constexpr float LOG2E = 1.4426950408889634f;
constexpr int NPHASE = 31;

__device__ __forceinline__ int otid() { int t = threadIdx.x; asm volatile("" : "+v"(t)); return t; }
__device__ __forceinline__ int batch_of(int row) { return row < T_PROMPT ? (row >> 12) : 8; }
__device__ __forceinline__ int seq0_of(int b) { return b < 8 ? b * L_P : T_PROMPT; }
__device__ __forceinline__ int seqlen_of(int b) { return b < 8 ? L_P : L_S; }
__device__ __forceinline__ unsigned pk_bf16(float lo, float hi) {
    typedef float f2_t __attribute__((ext_vector_type(2))); typedef __bf16 b2_t __attribute__((ext_vector_type(2)));
    f2_t v = {lo, hi}; b2_t b = __builtin_convertvector(v, b2_t); return __builtin_bit_cast(unsigned, b);
}
__device__ __forceinline__ bf16_t f2bf(float x) { return (bf16_t)(pk_bf16(x, 0.f) & 0xffffu); }
__device__ __forceinline__ float bf2f(bf16_t v) { return __uint_as_float((unsigned)v << 16); }
__device__ __forceinline__ float wave_sum(float v) {
#pragma unroll
    for (int o = 1; o < 64; o <<= 1) v += __shfl_xor(v, o);
    return v;
}
__device__ __forceinline__ float fast_exp2(float x) { return __builtin_amdgcn_exp2f(x); }
__device__ __forceinline__ float silu_f(float a) { return a * __builtin_amdgcn_rcpf(1.f + fast_exp2(-a * LOG2E)); }

constexpr size_t MiB = 1u << 20;
constexpr size_t WS_MOD = 1 * MiB;
constexpr size_t WS_BAR = 65536;
constexpr size_t WS_ROPE = 2 * MiB;
constexpr size_t WS_W = 4 * MiB;
constexpr size_t SZ_WINAB = (size_t)AB_IN * DM * 2, SZ_WOUT = (size_t)DM * DM * 2, SZ_WINCD = (size_t)CD_IN * DM * 2, SZ_W13 = (size_t)2 * DFF * DM * 2, SZ_W2 = (size_t)DM * DFF * 2;
constexpr size_t WS_WINAB = WS_W, WS_WOUTAB = WS_WINAB + 2 * SZ_WINAB, WS_WINCD = WS_WOUTAB + 2 * SZ_WOUT, WS_WOUTCD = WS_WINCD + 2 * SZ_WINCD,
                 WS_W13 = WS_WOUTCD + 2 * SZ_WOUT, WS_W2 = WS_W13 + 4 * SZ_W13, WS_WEND = WS_W2 + 4 * SZ_W2;
static_assert(WS_WEND <= 100 * MiB, "weights region");
constexpr size_t WS_H = 100 * MiB;
constexpr size_t WS_Z = 196 * MiB;
constexpr size_t WS_STASH = 460 * MiB;
constexpr size_t WS_NEED = 492 * MiB;

constexpr int LDS_BYTES = 131072 + 1024;

struct Args { const float* in[28]; float* out; unsigned char* ws; int ph_lo, ph_hi; };

struct EpiInAB {
    static constexpr bool PERM = true, AFTER_DRAIN = false;
    bf16_t* Z; const float* qg; const float* kg; const float* rope;
    __device__ __forceinline__ void operator()(const f32x4 (&acc)[2][2][4][2], const Unit& u, int wr, int wc, int fr, int fq) const {
        const int pn = u.pn;
        const int lcol = pn * 256 + wc * 64 + fq * 8;
        const bool isq = (pn == 6 || pn == 7), isk = (pn == 8 && wc < 2);
        const float* gsrc = isq ? qg : kg;
        f32x4 gv[2][2];
#pragma unroll
        for (int bj = 0; bj < 2; ++bj)
#pragma unroll
            for (int n = 0; n < 2; ++n) gv[bj][n] = *(const f32x4*)(gsrc + bj * 32 + fq * 8 + n * 4);
        const float qs = (pn < 2 || isq) ? C2 : 1.f;
#pragma unroll
        for (int ai = 0; ai < 2; ++ai)
#pragma unroll
            for (int m = 0; m < 4; ++m) {
                const int row = u.pm * 256 + ai * 128 + wr * 64 + m * 16 + fr;
                f32x4 v[2][2];
#pragma unroll
                for (int bj = 0; bj < 2; ++bj)
#pragma unroll
                    for (int n = 0; n < 2; ++n) v[bj][n] = acc[ai][bj][m][n];
                if (isq || isk) {
                    float ss = 0.f;
#pragma unroll
                    for (int bj = 0; bj < 2; ++bj)
#pragma unroll
                        for (int n = 0; n < 2; ++n) ss += (v[bj][n][0] * v[bj][n][0] + v[bj][n][1] * v[bj][n][1]) + (v[bj][n][2] * v[bj][n][2] + v[bj][n][3] * v[bj][n][3]);
                    ss += __shfl_xor(ss, 16); ss += __shfl_xor(ss, 32);
                    const float rstd = __builtin_amdgcn_rsqf(ss * (1.f / 64.f) + 1e-6f);
                    const int t = row < T_PROMPT ? (row & (L_P - 1)) : (row - T_PROMPT);
                    const int prow = t >> 6, pcol = t & 63;
#pragma unroll
                    for (int bj = 0; bj < 2; ++bj) {
                        const float* rp = rope + ((bj == 0 ? prow : pcol) * 16 + fq * 4) * 2;
#pragma unroll
                        for (int n = 0; n < 2; ++n) {
                            const f32x4 cs = *(const f32x4*)(rp + n * 4);
                            const f32x4 y = v[bj][n] * rstd * gv[bj][n];
                            f32x4 o;
                            o[0] = y[0] * cs[0] - y[1] * cs[1]; o[1] = y[0] * cs[1] + y[1] * cs[0];
                            o[2] = y[2] * cs[2] - y[3] * cs[3]; o[3] = y[2] * cs[3] + y[3] * cs[2];
                            v[bj][n] = o;
                        }
                    }
                }
                bf16_t* zp = Z + (size_t)row * AB_IN + lcol;
#pragma unroll
                for (int bj = 0; bj < 2; ++bj) {
                    const f32x4 a = v[bj][0] * qs, b = v[bj][1] * qs;
                    u32x4 w; w.x = pk_bf16(a[0], a[1]); w.y = pk_bf16(a[2], a[3]); w.z = pk_bf16(b[0], b[1]); w.w = pk_bf16(b[2], b[3]);
                    *(u32x4*)(zp + bj * 32) = w;
                }
            }
    }
};
struct EpiInCD {
    static constexpr bool PERM = true, AFTER_DRAIN = false;
    bf16_t* Z; unsigned* nrm;
    __device__ __forceinline__ void operator()(const f32x4 (&acc)[2][2][4][2], const Unit& u, int wr, int wc, int fr, int fq) const {
        const int pn = u.pn;
        const int lcol = pn * 256 + wc * 64 + fq * 8;
        const float qs = (pn == 4 || pn == 5) ? C2 : 1.f;
        if (pn >= 4 && pn < 8) {
            float mx = 0.f;
#pragma unroll
            for (int ai = 0; ai < 2; ++ai)
#pragma unroll
                for (int m = 0; m < 4; ++m) {
                    float ss = 0.f;
#pragma unroll
                    for (int bj = 0; bj < 2; ++bj)
#pragma unroll
                        for (int n = 0; n < 2; ++n) { const f32x4 v = acc[ai][bj][m][n] * qs; ss += (v[0] * v[0] + v[1] * v[1]) + (v[2] * v[2] + v[3] * v[3]); }
                    ss += __shfl_xor(ss, 16); ss += __shfl_xor(ss, 32);
                    mx = fmaxf(mx, ss);
                }
            mx = fmaxf(mx, __shfl_xor(mx, 1)); mx = fmaxf(mx, __shfl_xor(mx, 2)); mx = fmaxf(mx, __shfl_xor(mx, 4)); mx = fmaxf(mx, __shfl_xor(mx, 8));
            if (fr == 0 && fq == 0) atomicMax(nrm + (pn - 4) * 4 + wc, __float_as_uint(mx));
        }
#pragma unroll
        for (int ai = 0; ai < 2; ++ai)
#pragma unroll
            for (int m = 0; m < 4; ++m) {
                const int row = u.pm * 256 + ai * 128 + wr * 64 + m * 16 + fr;
                bf16_t* zp = Z + (size_t)row * CD_IN + lcol;
#pragma unroll
                for (int bj = 0; bj < 2; ++bj) {
                    const f32x4 a = acc[ai][bj][m][0] * qs, b = acc[ai][bj][m][1] * qs;
                    u32x4 w; w.x = pk_bf16(a[0], a[1]); w.y = pk_bf16(a[2], a[3]); w.z = pk_bf16(b[0], b[1]); w.w = pk_bf16(b[2], b[3]);
                    *(u32x4*)(zp + bj * 32) = w;
                }
            }
    }
};
template <bool FIRST>
struct EpiRes {
    static constexpr bool PERM = true, AFTER_DRAIN = false;
    const float* base_p; const float* base_s; bf16_t* xb; const float* gate;
    bf16_t* xw;
    __device__ __forceinline__ void operator()(const f32x4 (&acc)[2][2][4][2], const Unit& u, int wr, int wc, int fr, int fq) const {
        const int col0 = u.pn * 256 + wc * 32 + fq * 8;
        const int b = batch_of(u.pm * 256);
        const float* gp = gate + b * 6144 + col0;
        f32x4 g1[2][2];
#pragma unroll
        for (int bj = 0; bj < 2; ++bj)
#pragma unroll
            for (int n = 0; n < 2; ++n) g1[bj][n] = *(const f32x4*)(gp + bj * 128 + n * 4) + 1.f;
#pragma unroll
        for (int ai = 0; ai < 2; ++ai) {
            const int row0 = u.pm * 256 + ai * 128 + wr * 64 + fr;
            bf16_t* op = xb + (size_t)row0 * DM + col0; bf16_t* ow = xw + (size_t)row0 * DM + col0;
            if constexpr (FIRST) {
                const float* bp = (row0 < T_PROMPT ? base_p + (size_t)row0 * DM : base_s + (size_t)(row0 - T_PROMPT) * DM) + col0;
#pragma unroll
                for (int mh = 0; mh < 4; mh += 2) {
                    f32x4 xv[2][2][2];
#pragma unroll
                    for (int m = 0; m < 2; ++m)
#pragma unroll
                        for (int bj = 0; bj < 2; ++bj)
#pragma unroll
                            for (int n = 0; n < 2; ++n) xv[m][bj][n] = *(const f32x4*)(bp + (size_t)((mh + m) * 16) * DM + bj * 128 + n * 4);
#pragma unroll
                    for (int m = 0; m < 2; ++m)
#pragma unroll
                        for (int bj = 0; bj < 2; ++bj) {
                            const f32x4 a = xv[m][bj][0] + g1[bj][0] * acc[ai][bj][mh + m][0], c = xv[m][bj][1] + g1[bj][1] * acc[ai][bj][mh + m][1];
                            u32x4 w; w.x = pk_bf16(a[0], a[1]); w.y = pk_bf16(a[2], a[3]); w.z = pk_bf16(c[0], c[1]); w.w = pk_bf16(c[2], c[3]);
                            *(u32x4*)(ow + (size_t)((mh + m) * 16) * DM + bj * 128) = w;
                        }
                }
            } else {
                u32x4 xv[4][2];
#pragma unroll
                for (int m = 0; m < 4; ++m)
#pragma unroll
                    for (int bj = 0; bj < 2; ++bj) xv[m][bj] = *(const u32x4*)(op + (size_t)(m * 16) * DM + bj * 128);
#pragma unroll
                for (int m = 0; m < 4; ++m)
#pragma unroll
                    for (int bj = 0; bj < 2; ++bj) {
                        const u32x4 x = xv[m][bj];
                        const f32x4 x0 = {__uint_as_float(x.x << 16), __uint_as_float(x.x & 0xffff0000u), __uint_as_float(x.y << 16), __uint_as_float(x.y & 0xffff0000u)};
                        const f32x4 x1 = {__uint_as_float(x.z << 16), __uint_as_float(x.z & 0xffff0000u), __uint_as_float(x.w << 16), __uint_as_float(x.w & 0xffff0000u)};
                        const f32x4 a = x0 + g1[bj][0] * acc[ai][bj][m][0], c = x1 + g1[bj][1] * acc[ai][bj][m][1];
                        u32x4 w; w.x = pk_bf16(a[0], a[1]); w.y = pk_bf16(a[2], a[3]); w.z = pk_bf16(c[0], c[1]); w.w = pk_bf16(c[2], c[3]);
                        *(u32x4*)(ow + (size_t)(m * 16) * DM + bj * 128) = w;
                    }
            }
        }
    }
};
struct EpiResAt {
    static constexpr bool PERM = true, AFTER_DRAIN = false;
    float* out; const float* gate;
    __device__ __forceinline__ void operator()(const f32x4 (&acc)[2][2][4][2], const Unit& u, int wr, int wc, int fr, int fq) const {
        const int col0 = u.pn * 256 + wc * 32 + fq * 8;
        const int b = batch_of(u.pm * 256);
        const float* gp = gate + b * 6144 + col0;
        f32x4 g1[2][2];
#pragma unroll
        for (int bj = 0; bj < 2; ++bj)
#pragma unroll
            for (int n = 0; n < 2; ++n) g1[bj][n] = *(const f32x4*)(gp + bj * 128 + n * 4) + 1.f;
#pragma unroll
        for (int ai = 0; ai < 2; ++ai)
#pragma unroll
            for (int m = 0; m < 4; ++m) {
                float* op = out + (size_t)(u.pm * 256 + ai * 128 + wr * 64 + m * 16 + fr) * DM + col0;
#pragma unroll
                for (int bj = 0; bj < 2; ++bj)
#pragma unroll
                    for (int n = 0; n < 2; ++n) {
                        const f32x4 v = g1[bj][n] * acc[ai][bj][m][n];
#pragma unroll
                        for (int e = 0; e < 4; ++e) unsafeAtomicAdd(op + bj * 128 + n * 4 + e, v[e]);
                    }
            }
    }
};
struct EpiUp {
    static constexpr bool PERM = true, AFTER_DRAIN = false;
    bf16_t* U;
    __device__ __forceinline__ void operator()(const f32x4 (&acc)[2][2][4][2], const Unit& u, int wr, int wc, int fr, int fq) const {
        const int col0 = u.pn * 128 + wc * 32 + fq * 8;
#pragma unroll
        for (int ai = 0; ai < 2; ++ai)
#pragma unroll
            for (int m = 0; m < 4; ++m) {
                const int row = u.pm * 256 + ai * 128 + wr * 64 + m * 16 + fr;
                f32x4 r[2];
#pragma unroll
                for (int n = 0; n < 2; ++n) {
                    const f32x4 a = acc[ai][0][m][n], g = acc[ai][1][m][n];
#pragma unroll
                    for (int e = 0; e < 4; ++e) r[n][e] = (a[e] * g[e]) * __builtin_amdgcn_rcpf(1.f + fast_exp2(a[e]));
                }
                u32x4 w; w.x = pk_bf16(r[0][0], r[0][1]); w.y = pk_bf16(r[0][2], r[0][3]); w.z = pk_bf16(r[1][0], r[1][1]); w.w = pk_bf16(r[1][2], r[1][3]);
                *(u32x4*)(U + (size_t)row * DFF + col0) = w;
            }
    }
};

constexpr int KBUF = 8192, ATT_TAB = 65536;
#ifndef PIPE128
#define PIPE128 1
#endif
__device__ __forceinline__ s16x4 tr_read(const LAS unsigned char* p) {
    typedef short v4i16_t __attribute__((ext_vector_type(4)));
    return __builtin_bit_cast(s16x4, __builtin_amdgcn_ds_read_tr16_b64_v4i16((LAS v4i16_t*)p));
}
__device__ __forceinline__ int crow(int r, int hi) { return (r & 3) + 8 * (r >> 2) + 4 * hi; }

__device__ __forceinline__ void glds16(const void* gsrc, unsigned lds_dst) {
    unsigned keep;
    asm volatile("s_mov_b32 %0, m0\n\ts_mov_b32 m0, %2\n\ts_nop 0\n\tglobal_load_lds_dwordx4 %1, off\n\ts_mov_b32 m0, %0" : "=&s"(keep) : "v"(gsrc), "s"(lds_dst) : "memory");
}
template <bool SPLIT>
__device__ __forceinline__ void qk_tile(const LAS unsigned char* Ks, const bf16x8 (&qr)[4], f32x16& s0, f32x16& s1) {
    const f32x16 zero16 = {0.f, 0.f, 0.f, 0.f, 0.f, 0.f, 0.f, 0.f, 0.f, 0.f, 0.f, 0.f, 0.f, 0.f, 0.f, 0.f};
    s0 = zero16; s1 = zero16;
#pragma unroll
    for (int d0 = 0; d0 < 4; ++d0) {
        const bf16x8 b0 = *(const LAS bf16x8*)(Ks + d0 * 256);
        const bf16x8 b1 = *(const LAS bf16x8*)(Ks + d0 * 256 + 4096);
        s0 = __builtin_amdgcn_mfma_f32_32x32x16_bf16(b0, qr[d0], s0, 0, 0, 0);
        s1 = __builtin_amdgcn_mfma_f32_32x32x16_bf16(b1, qr[d0], s1, 0, 0, 0);
        if (SPLIT && d0 == 1) __builtin_amdgcn_sched_barrier(0);
    }
}
__device__ __forceinline__ void qk_tile_c(const LAS unsigned char* Ks, const bf16x8 (&qr)[4], f32x16& s0, f32x16& s1, const f32x16& cinit) {
#pragma unroll
    for (int d0 = 0; d0 < 4; ++d0) {
        const bf16x8 b0 = *(const LAS bf16x8*)(Ks + d0 * 256);
        const bf16x8 b1 = *(const LAS bf16x8*)(Ks + d0 * 256 + 4096);
        s0 = __builtin_amdgcn_mfma_f32_32x32x16_bf16(b0, qr[d0], d0 == 0 ? cinit : s0, 0, 0, 0);
        s1 = __builtin_amdgcn_mfma_f32_32x32x16_bf16(b1, qr[d0], d0 == 0 ? cinit : s1, 0, 0, 0);
    }
}
template <int MODE>
__device__ __forceinline__ void apply_bias(f32x16& s0, f32x16& s1, int t, int hi, float slope2, int qpos, const LAS float* na_tab, int na_d0, int na_qc, int na_cs) {
    if constexpr (MODE == 1 && !defined_TA) {
        const float kbf = (float)(t * 64 + 4 * hi - qpos);
#pragma unroll
        for (int i = 0; i < 16; ++i) {
            const float c = (float)((i & 3) + 8 * (i >> 2));
            s0[i] = fmaf(-slope2, fabsf(kbf + c), s0[i]);
            s1[i] = fmaf(-slope2, fabsf(kbf + (c + 32.f)), s1[i]);
        }
    }
    if constexpr (MODE == 2) {
        const volatile LAS float* tb = na_tab + (t + na_d0) * 31 + (79 - na_qc + 4 * hi);
        const int cb = 4 * hi - na_cs;
        float bv0[16], bv1[16];
#pragma unroll
        for (int i = 0; i < 16; ++i) { const int c = (i & 3) + 8 * (i >> 2); bv0[i] = tb[c]; bv1[i] = tb[c + 32]; }
#pragma unroll
        for (int i = 0; i < 16; ++i) {
            const int c = (i & 3) + 8 * (i >> 2);
            s0[i] = ((unsigned)(cb + c) < 16u) ? s0[i] + bv0[i] : -1e30f;
            s1[i] = ((unsigned)(cb + c + 32) < 16u) ? s1[i] + bv1[i] : -1e30f;
        }
    }
}
template <int NDB>
__device__ __forceinline__ void max_rescale(f32x16& s0, f32x16& s1, f32x16 (&o)[NDB], float& mref, float& lacc, int hi) {
    constexpr float THR = 6.f;
#pragma unroll
    for (int i = 0; i < 16; ++i) { s0[i] -= mref; s1[i] -= mref; }
    float ra = fmaxf(fmaxf(s0[0], s1[0]), s0[1]), rb = fmaxf(fmaxf(s1[1], s0[2]), s1[2]);
#pragma unroll
    for (int i = 3; i < 15; i += 2) { ra = fmaxf(fmaxf(ra, s0[i]), s1[i]); rb = fmaxf(fmaxf(rb, s0[i + 1]), s1[i + 1]); }
    float rm = fmaxf(fmaxf(ra, rb), fmaxf(s0[15], s1[15]));
    rm = fmaxf(rm, __shfl_xor(rm, 32));
    if (__any(rm > THR)) {
        const float dl = fmaxf(rm, 0.f);
        const float f = fast_exp2(-dl);
        lacc *= f; mref += dl;
#pragma unroll
        for (int i = 0; i < 16; ++i) { s0[i] -= dl; s1[i] -= dl; }
#pragma unroll
        for (int r = 0; r < 16; ++r) {
            const float fq_ = __shfl(f, crow(r, hi));
#pragma unroll
            for (int d = 0; d < NDB; ++d) o[d][r] *= fq_;
        }
    }
}
template <int NDB>
__device__ __forceinline__ void max_rescale_c(f32x16& s0, f32x16& s1, f32x16 (&o)[NDB], float& mref, float& lacc, int hi, f32x16& negm) {
    constexpr float THR = 6.f;
    float ra = fmaxf(fmaxf(s0[0], s1[0]), s0[1]), rb = fmaxf(fmaxf(s1[1], s0[2]), s1[2]);
#pragma unroll
    for (int i = 3; i < 15; i += 2) { ra = fmaxf(fmaxf(ra, s0[i]), s1[i]); rb = fmaxf(fmaxf(rb, s0[i + 1]), s1[i + 1]); }
    float rm = fmaxf(fmaxf(ra, rb), fmaxf(s0[15], s1[15]));
    rm = fmaxf(rm, __shfl_xor(rm, 32));
    if (__any(rm > THR)) {
        const float dl = fmaxf(rm, 0.f);
        const float f = fast_exp2(-dl);
        lacc *= f; mref += dl;
#pragma unroll
        for (int i = 0; i < 16; ++i) { s0[i] -= dl; s1[i] -= dl; negm[i] = -mref; }
        asm volatile("" : "+v"(negm));
#pragma unroll
        for (int r = 0; r < 16; ++r) {
            const float fq_ = __shfl(f, crow(r, hi));
#pragma unroll
            for (int d = 0; d < NDB; ++d) o[d][r] *= fq_;
        }
    }
}
template <int NDB>
__device__ __forceinline__ void softmax_pv(const LAS unsigned char* Vs, f32x16& s0, f32x16& s1, f32x16 (&o)[NDB], float& lacc) {
    float sum = 0.f;
#pragma unroll
    for (int i = 0; i < 16; ++i) { s0[i] = fast_exp2(s0[i]); s1[i] = fast_exp2(s1[i]); sum += s0[i] + s1[i]; }
    lacc += sum;
    bf16x8 pa[4];
    {
        u32x4 w;
        w.x = pk_bf16(s0[0], s0[1]); w.y = pk_bf16(s0[2], s0[3]); w.z = pk_bf16(s0[4], s0[5]); w.w = pk_bf16(s0[6], s0[7]); pa[0] = __builtin_bit_cast(bf16x8, w);
        w.x = pk_bf16(s0[8], s0[9]); w.y = pk_bf16(s0[10], s0[11]); w.z = pk_bf16(s0[12], s0[13]); w.w = pk_bf16(s0[14], s0[15]); pa[1] = __builtin_bit_cast(bf16x8, w);
        w.x = pk_bf16(s1[0], s1[1]); w.y = pk_bf16(s1[2], s1[3]); w.z = pk_bf16(s1[4], s1[5]); w.w = pk_bf16(s1[6], s1[7]); pa[2] = __builtin_bit_cast(bf16x8, w);
        w.x = pk_bf16(s1[8], s1[9]); w.y = pk_bf16(s1[10], s1[11]); w.z = pk_bf16(s1[12], s1[13]); w.w = pk_bf16(s1[14], s1[15]); pa[3] = __builtin_bit_cast(bf16x8, w);
    }
#pragma unroll
    for (int db = 0; db < NDB; ++db) {
#pragma unroll
        for (int i = 0; i < 4; ++i) {
            const s16x4 lo = tr_read(Vs + db * 4096 + i * 1024);
            const s16x4 hi4 = tr_read(Vs + db * 4096 + i * 1024 + 512);
            const bf16x8 vf = {lo[0], lo[1], lo[2], lo[3], hi4[0], hi4[1], hi4[2], hi4[3]};
            o[db] = __builtin_amdgcn_mfma_f32_32x32x16_bf16(pa[i], vf, o[db], 0, 0, 0);
        }
    }
}

template <int NOMAX>
__device__ __forceinline__ void step_hs(const LAS unsigned char* Ks, const LAS unsigned char* Vs, const bf16x8 (&qr)[4], f32x16& C0, f32x16& C1, f32x16& N0, f32x16& N1,
                                        f32x16 (&o)[2], float& mref, float& lacc, int hi, f32x16& negm) {
#define SBAR() __builtin_amdgcn_sched_barrier(0)
    bf16x8 kf[8];
#pragma unroll
    for (int c = 0; c < 8; ++c) kf[c] = *(const LAS bf16x8*)(Ks + (c & 3) * 256 + (c >> 2) * 4096);
    unsigned pw[16]; float sum = 0.f;
#define EXP2P(C, e, w) do { const float e0_ = fast_exp2(C[e]), e1_ = fast_exp2(C[(e) + 1]); sum += e0_ + e1_; pw[w] = pk_bf16(e0_, e1_); } while (0)
    SBAR();
#pragma unroll
    for (int j = 0; j < 8; ++j) {
        if (j < 4) N0 = __builtin_amdgcn_mfma_f32_32x32x16_bf16(kf[j], qr[j], j == 0 ? negm : N0, 0, 0, 0);
        else       N1 = __builtin_amdgcn_mfma_f32_32x32x16_bf16(kf[j], qr[j - 4], j == 4 ? negm : N1, 0, 0, 0);
        EXP2P(C0, 2 * j, j);
        SBAR();
    }
    s16x4 vlo[8], vhi[8];
#pragma unroll
    for (int j = 0; j < 4; ++j) { vlo[j] = tr_read(Vs + (j & 1) * 4096 + (j >> 1) * 1024); vhi[j] = tr_read(Vs + (j & 1) * 4096 + (j >> 1) * 1024 + 512); }
    float ra = -3.0e38f, rb = -3.0e38f;
    SBAR();
#pragma unroll
    for (int j = 0; j < 8; ++j) {
        if (j + 4 < 8) { const int jj = j + 4; vlo[jj] = tr_read(Vs + (jj & 1) * 4096 + (jj >> 1) * 1024); vhi[jj] = tr_read(Vs + (jj & 1) * 4096 + (jj >> 1) * 1024 + 512); }
        const bf16x8 vf = {vlo[j][0], vlo[j][1], vlo[j][2], vlo[j][3], vhi[j][0], vhi[j][1], vhi[j][2], vhi[j][3]};
        const int i = j >> 1;
        const u32x4 w = {pw[4 * i], pw[4 * i + 1], pw[4 * i + 2], pw[4 * i + 3]};
        const bf16x8 pa = __builtin_bit_cast(bf16x8, w);
        if (j & 1) o[1] = __builtin_amdgcn_mfma_f32_32x32x16_bf16(pa, vf, o[1], 0, 0, 0);
        else       o[0] = __builtin_amdgcn_mfma_f32_32x32x16_bf16(pa, vf, o[0], 0, 0, 0);
        if (j < 4) EXP2P(C1, 2 * j, 8 + j);
        if (j >= 2 && j < 6) EXP2P(C1, 8 + 2 * (j - 2), 12 + (j - 2));
        const int bs = (j & 3) * 4;
        if constexpr (!NOMAX) {
        if (j < 4) { ra = fmaxf(fmaxf(ra, N0[bs]), N0[bs + 1]); rb = fmaxf(fmaxf(rb, N0[bs + 2]), N0[bs + 3]); }
        else       { ra = fmaxf(fmaxf(ra, N1[bs]), N1[bs + 1]); rb = fmaxf(fmaxf(rb, N1[bs + 2]), N1[bs + 3]); }
        }
        SBAR();
    }
    lacc += sum;
#undef EXP2P
    if constexpr (NOMAX) return;
    float rm = fmaxf(ra, rb);
    rm = fmaxf(rm, __shfl_xor(rm, 32));
    if (__any(rm > 6.f)) {
        const float dl = fmaxf(rm, 0.f);
        const float f = fast_exp2(-dl);
        lacc *= f; mref += dl;
#pragma unroll
        for (int i = 0; i < 16; ++i) { N0[i] -= dl; N1[i] -= dl; negm[i] = -mref; }
        asm volatile("" : "+v"(negm));
#pragma unroll
        for (int r = 0; r < 16; ++r) {
            const float fq_ = __shfl(f, crow(r, hi));
            o[0][r] *= fq_; o[1][r] *= fq_;
        }
    }
#undef SBAR
}

__device__ __forceinline__ void step_hs128(const LAS unsigned char* Ks, const LAS unsigned char* Vs, const bf16x8 (&qr)[4], f32x16& C0, f32x16& C1, f32x16& N0, f32x16& N1,
                                           f32x16 (&o)[4], float& mref, float& lacc, int hi, float slope2, int qpos, int tn, f32x16& negm) {
#define SBAR() __builtin_amdgcn_sched_barrier(0)
#define KFRAG(c) (*(const LAS bf16x8*)(Ks + ((c) & 3) * 256 + ((c) >> 2) * 4096))
    bf16x8 kf[8];
    kf[0] = KFRAG(0); kf[1] = KFRAG(1);
    unsigned pw[16]; float sum = 0.f;
    SBAR();
#pragma unroll
    for (int j = 0; j < 8; ++j) {
        if (j + 2 < 8) kf[j + 2] = KFRAG(j + 2);
        if (j < 4) N0 = __builtin_amdgcn_mfma_f32_32x32x16_bf16(kf[j], qr[j], j == 0 ? negm : N0, 0, 0, 0);
        else       N1 = __builtin_amdgcn_mfma_f32_32x32x16_bf16(kf[j], qr[j - 4], j == 4 ? negm : N1, 0, 0, 0);
        const int bs = (j & 3) * 4;
        float e0, e1, e2, e3;
        if (j < 4) { e0 = fast_exp2(C0[bs]); e1 = fast_exp2(C0[bs + 1]); e2 = fast_exp2(C0[bs + 2]); e3 = fast_exp2(C0[bs + 3]); }
        else       { e0 = fast_exp2(C1[bs]); e1 = fast_exp2(C1[bs + 1]); e2 = fast_exp2(C1[bs + 2]); e3 = fast_exp2(C1[bs + 3]); }
        sum += (e0 + e1) + (e2 + e3);
        pw[2 * j] = pk_bf16(e0, e1); pw[2 * j + 1] = pk_bf16(e2, e3);
        SBAR();
    }
    lacc += sum;
    bf16x8 pa[4];
#pragma unroll
    for (int i = 0; i < 4; ++i) { u32x4 w = {pw[4 * i], pw[4 * i + 1], pw[4 * i + 2], pw[4 * i + 3]}; pa[i] = __builtin_bit_cast(bf16x8, w); }
    s16x4 vlo[16], vhi[16];
#define VOFFS(j) (((j) & 3) * 4096 + ((j) >> 2) * 1024)
    vlo[0] = tr_read(Vs + VOFFS(0)); vhi[0] = tr_read(Vs + VOFFS(0) + 512);
    vlo[1] = tr_read(Vs + VOFFS(1)); vhi[1] = tr_read(Vs + VOFFS(1) + 512);
    float ra = -3.0e38f, rb = -3.0e38f;
    const float kbf = (float)(tn * 64 + 4 * hi - qpos);
    SBAR();
#pragma unroll
    for (int j = 0; j < 16; ++j) {
        if (j + 2 < 16) { vlo[j + 2] = tr_read(Vs + VOFFS(j + 2)); vhi[j + 2] = tr_read(Vs + VOFFS(j + 2) + 512); }
        const bf16x8 vf = {vlo[j][0], vlo[j][1], vlo[j][2], vlo[j][3], vhi[j][0], vhi[j][1], vhi[j][2], vhi[j][3]};
        if ((j & 3) == 0)      o[0] = __builtin_amdgcn_mfma_f32_32x32x16_bf16(pa[j >> 2], vf, o[0], 0, 0, 0);
        else if ((j & 3) == 1) o[1] = __builtin_amdgcn_mfma_f32_32x32x16_bf16(pa[j >> 2], vf, o[1], 0, 0, 0);
        else if ((j & 3) == 2) o[2] = __builtin_amdgcn_mfma_f32_32x32x16_bf16(pa[j >> 2], vf, o[2], 0, 0, 0);
        else                   o[3] = __builtin_amdgcn_mfma_f32_32x32x16_bf16(pa[j >> 2], vf, o[3], 0, 0, 0);
        {
            const int e = (2 * j) & 15;
            const float c0 = (float)((e & 3) + 8 * (e >> 2) + (j >= 8 ? 32 : 0)), c1 = (float)(((e + 1) & 3) + 8 * ((e + 1) >> 2) + (j >= 8 ? 32 : 0));
            if (j < 8) {
                N0[e] = fmaf(-slope2, fabsf(kbf + c0), N0[e]); N0[e + 1] = fmaf(-slope2, fabsf(kbf + c1), N0[e + 1]);
                if (j & 1) rb = fmaxf(fmaxf(rb, N0[e]), N0[e + 1]); else ra = fmaxf(fmaxf(ra, N0[e]), N0[e + 1]);
            } else {
                N1[e] = fmaf(-slope2, fabsf(kbf + c0), N1[e]); N1[e + 1] = fmaf(-slope2, fabsf(kbf + c1), N1[e + 1]);
                if (j & 1) rb = fmaxf(fmaxf(rb, N1[e]), N1[e + 1]); else ra = fmaxf(fmaxf(ra, N1[e]), N1[e + 1]);
            }
        }
        SBAR();
    }
    float rm = fmaxf(ra, rb);
    rm = fmaxf(rm, __shfl_xor(rm, 32));
    if (__any(rm > 6.f)) {
        const float dl = fmaxf(rm, 0.f);
        const float f = fast_exp2(-dl);
        lacc *= f; mref += dl;
#pragma unroll
        for (int i = 0; i < 16; ++i) { N0[i] -= dl; N1[i] -= dl; negm[i] = -mref; }
        asm volatile("" : "+v"(negm));
#pragma unroll
        for (int r = 0; r < 16; ++r) {
            const float fq_ = __shfl(f, crow(r, hi));
            o[0][r] *= fq_; o[1][r] *= fq_; o[2][r] *= fq_; o[3][r] *= fq_;
        }
    }
#undef SBAR
#undef KFRAG
#undef VOFFS
}

template <int DV, int MODE, int NMAP, int NOMAX = 0>
__device__ __forceinline__ void flash_core(LAS unsigned char* lds, const bf16_t* __restrict__ Kg, int ldk, const bf16_t* __restrict__ Vg, int ldv, int nt,
                                           const bf16x8 (&qr)[4], f32x16 (&o)[DV / 32], float& ltot,
                                           float slope2, int qpos, int na_tlo, int na_d0, int na_qc) {
    constexpr int NDB = DV / 32, VBUF = DV * 128, KST = NMAP * KBUF, VOFF = 3 * KST, NOPS = NMAP + DV / 64;
    static_assert(NOPS == 2 || NOPS == 4, "counted waits below");
    const int tid = otid(), lane = tid & 63, r32 = lane & 31, hi = lane >> 5, wid = tid >> 6;
    const int mp = NMAP == 2 ? (wid >> 2) : 0;
    const int widu = __builtin_amdgcn_readfirstlane(wid);
    const unsigned lds0 = (unsigned)(uintptr_t)lds;
    const bf16_t* ksrc = Kg + (size_t)(widu * 8 + (lane & 7)) * ldk + ((lane >> 3) ^ ((widu >> 1) & 1)) * 8;
    const bf16_t* vsrc = Vg + (size_t)(16 * (widu & 3) + (lane >> 2)) * ldv + (widu >> 2) * 32 + (lane & 3) * 8;
    const unsigned kdst = lds0 + widu * 1024, vdst = lds0 + VOFF + (widu >> 2) * 4096 + (widu & 3) * 1024;
    const int kro = mp * KBUF + (r32 >> 3) * 1024 + (r32 & 7) * 16 + (hi ^ ((r32 >> 4) & 1)) * 128;
    const int vro = VOFF + (4 * hi + ((lane & 15) >> 2)) * 64 + ((lane >> 4) & 1) * 32 + (lane & 3) * 8;
    const f32x16 zero16 = {0.f, 0.f, 0.f, 0.f, 0.f, 0.f, 0.f, 0.f, 0.f, 0.f, 0.f, 0.f, 0.f, 0.f, 0.f, 0.f};
#pragma unroll
    for (int d = 0; d < NDB; ++d) o[d] = zero16;
    float mref = 0.f, lacc = 0.f;
    const int na_cs = MODE == 2 ? min(max(na_qc - 8, 0), 48) : 0;
    const LAS float* na_tab = (const LAS float*)(lds + ATT_TAB);
    const int ntm1 = nt - 1;
#define FL_DMAK(tt, st) do { const bf16_t* p_ = ksrc + (size_t)min((tt), ntm1) * 64 * ldk; glds16(p_, (unsigned)__builtin_amdgcn_readfirstlane(kdst + (st) * KST)); \
        if constexpr (NMAP == 2) glds16(p_ + 64, (unsigned)__builtin_amdgcn_readfirstlane(kdst + (st) * KST + KBUF)); } while (0)
#define FL_DMAV(tt, st) do { const bf16_t* p_ = vsrc + (size_t)min((tt), ntm1) * 64 * ldv; glds16(p_, (unsigned)__builtin_amdgcn_readfirstlane(vdst + (st) * VBUF)); \
        if constexpr (DV == 128) glds16(p_ + 64, (unsigned)__builtin_amdgcn_readfirstlane(vdst + (st) * VBUF + 8192)); } while (0)
#define FL_WB_ALL() asm volatile("s_waitcnt vmcnt(0) lgkmcnt(0)\n\ts_barrier" ::: "memory")
#define FL_WB_ONE() do { if constexpr (NOPS == 2) asm volatile("s_waitcnt vmcnt(2) lgkmcnt(0)\n\ts_barrier" ::: "memory"); else asm volatile("s_waitcnt vmcnt(4) lgkmcnt(0)\n\ts_barrier" ::: "memory"); } while (0)
#define FL_NEXT(s) ((s) == 2 ? 0 : (s) + 1)
#define FL_ACT(tt) (MODE != 2 || (unsigned)((tt) - na_tlo) < 8u)
    asm volatile("" :: "v"(qr[0]), "v"(qr[1]), "v"(qr[2]), "v"(qr[3]));
    FL_WB_ALL();
    if constexpr (DV == 128 && !PIPE128) {
        f32x16 s0, s1;
        FL_DMAK(0, 0); FL_DMAV(0, 0);
        FL_DMAK(1, 1); FL_DMAV(1, 1);
        FL_WB_ONE();
        int st = 0;
        for (int t = 0; t < nt; ++t) {
            const int st2 = (st == 0) ? 2 : st - 1;
            FL_DMAK(t + 2, st2); FL_DMAV(t + 2, st2);
            qk_tile<false>(lds + st * KST + kro, qr, s0, s1);
            apply_bias<MODE>(s0, s1, t, hi, slope2, qpos, na_tab, na_d0, na_qc, na_cs);
            max_rescale<NDB>(s0, s1, o, mref, lacc, hi);
            softmax_pv<NDB>(lds + st * VBUF + vro, s0, s1, o, lacc);
            FL_WB_ONE();
            st = FL_NEXT(st);
        }
    } else {
        FL_DMAK(0, 0); FL_DMAV(0, 0); FL_DMAK(1, 1);
        FL_DMAK(2, 2); FL_DMAV(1, 1);
        FL_WB_ONE();
        f32x16 sa0, sa1, sb0, sb1;
        sa0 = zero16; sa1 = zero16; sb0 = zero16; sb1 = zero16;
        if (FL_ACT(0)) {
            qk_tile<false>(lds + kro, qr, sa0, sa1);
            apply_bias<MODE>(sa0, sa1, 0, hi, slope2, qpos, na_tab, na_d0, na_qc, na_cs);
            if constexpr (!NOMAX) max_rescale<NDB>(sa0, sa1, o, mref, lacc, hi);
        }
        f32x16 negm;
#pragma unroll
        for (int i = 0; i < 16; ++i) negm[i] = -mref;
        asm volatile("" : "+v"(negm));
        asm volatile("s_waitcnt lgkmcnt(0)\n\ts_barrier" ::: "memory");
        int sg = 0;
#define FL_BODY(C0, C1, N0, N1, T) do { \
        const int t_ = (T); const int sg1_ = FL_NEXT(sg), sg2_ = FL_NEXT(sg1_); \
        FL_DMAK(t_ + 3, sg); FL_DMAV(t_ + 2, sg2_); \
        const bool actc_ = FL_ACT(t_), actn_ = FL_ACT(t_ + 1); \
        if constexpr (MODE == 0 && DV == 64) { step_hs<NOMAX>(lds + sg1_ * KST + kro, lds + sg * VBUF + vro, qr, C0, C1, N0, N1, o, mref, lacc, hi, negm); } \
        else if constexpr (MODE == 1 && DV == 128) { step_hs128(lds + sg1_ * KST + kro, lds + sg * VBUF + vro, qr, C0, C1, N0, N1, o, mref, lacc, hi, slope2, qpos, t_ + 1, negm); } else { \
        if (actn_) qk_tile_c(lds + sg1_ * KST + kro, qr, N0, N1, negm); \
        if (actc_) softmax_pv<NDB>(lds + sg * VBUF + vro, C0, C1, o, lacc); \
        if (actn_) { apply_bias<MODE>(N0, N1, t_ + 1, hi, slope2, qpos, na_tab, na_d0, na_qc, na_cs); max_rescale_c<NDB>(N0, N1, o, mref, lacc, hi, negm); } } \
        FL_WB_ONE(); sg = sg1_; } while (0)
        int t = 0;
        for (; t + 2 < nt; t += 2) { FL_BODY(sa0, sa1, sb0, sb1, t); FL_BODY(sb0, sb1, sa0, sa1, t + 1); }
        if (t + 1 < nt) {
            FL_BODY(sa0, sa1, sb0, sb1, t);
            if (FL_ACT(t + 1)) softmax_pv<NDB>(lds + sg * VBUF + vro, sb0, sb1, o, lacc);
        } else {
            if (FL_ACT(t)) softmax_pv<NDB>(lds + sg * VBUF + vro, sa0, sa1, o, lacc);
        }
    }
    FL_WB_ALL();
#undef FL_DMAK
#undef FL_DMAV
#undef FL_WB_ALL
#undef FL_WB_ONE
#undef FL_NEXT
#undef FL_ACT
#undef FL_BODY
    ltot = lacc + __shfl_xor(lacc, 32);
}

__device__ __forceinline__ void gqa_unit(LAS unsigned char* lds, const bf16_t* Z, bf16_t* O, const float* qg, const float* kg, int b, int hq, int qb) {
    const int tid = otid(), lane = tid & 63, r32 = lane & 31, hi = lane >> 5, wid = tid >> 6;
    const int seq0 = seq0_of(b), L = seqlen_of(b);
    const size_t qrow = (size_t)seq0 + qb * 256 + wid * 32;
    const bf16_t* Qp = Z + (qrow + r32) * AB_IN + 1536 + hq * 64 + hi * 8;
    bf16x8 qr[4];
#pragma unroll
    for (int d0 = 0; d0 < 4; ++d0) qr[d0] = *(const bf16x8*)(Qp + d0 * 16);
    const int kvh = hq >> 2;
    f32x16 o[2]; float ltot;
    float gq = fabsf(qg[lane]), gk = fabsf(kg[lane]);
#pragma unroll
    for (int s_ = 1; s_ < 64; s_ <<= 1) { gq = fmaxf(gq, __shfl_xor(gq, s_)); gk = fmaxf(gk, __shfl_xor(gk, s_)); }
    const bool bounded = __builtin_amdgcn_readfirstlane(64.f * C2 * 1.05f * gq * gk <= 40.f ? 1 : 0) != 0;
    if (bounded) flash_core<64, 0, 1, 1>(lds, Z + (size_t)seq0 * AB_IN + 2048 + kvh * 64, AB_IN, Z + (size_t)seq0 * AB_IN + 2176 + kvh * 64, AB_IN, L / 64, qr, o, ltot, 0.f, 0, 0, 0, 0);
    else         flash_core<64, 0, 1, 0>(lds, Z + (size_t)seq0 * AB_IN + 2048 + kvh * 64, AB_IN, Z + (size_t)seq0 * AB_IN + 2176 + kvh * 64, AB_IN, L / 64, qr, o, ltot, 0.f, 0, 0, 0, 0);
    const float linv = 1.f / ltot;
    bf16_t* Op = O + qrow * DM + 512 + hq * 64 + r32;
#pragma unroll
    for (int r = 0; r < 16; ++r) {
        const int q = crow(r, hi); const float li = __shfl(linv, q);
#pragma unroll
        for (int d = 0; d < 2; ++d) Op[(size_t)q * DM + 32 * d] = f2bf(o[d][r] * li);
    }
}
__device__ __forceinline__ void na_unit(LAS unsigned char* lds, const bf16_t* Z, bf16_t* O, const float* rpb  , int b, int h, int R4) {
    const int tid = otid(), lane = tid & 63, r32 = lane & 31, hi = lane >> 5, wid = tid >> 6;
    const int seq0 = seq0_of(b), rows = seqlen_of(b) >> 6;
    const int r = 4 * R4 + (wid >> 1), half = wid & 1;
    const int kr0 = min(max(4 * R4 - 4, 0), rows - 8), kr1 = min(max(4 * R4 + 3 - 4, 0), rows - 8) + 8;
    const int rs = min(max(r - 4, 0), rows - 8);
    __syncthreads();
    {
        LAS float* tab = (LAS float*)(lds + ATT_TAB);
        for (int i = tid; i < 640; i += 512) { const int idx = i - 64; tab[i] = (idx >= 0 && idx < 465) ? rpb[h * 465 + idx] * LOG2E : 0.f; }
    }
    const size_t qrow = (size_t)seq0 + 64 * r + 32 * half;
    const bf16_t* Qp = Z + (qrow + r32) * AB_IN + h * 64 + hi * 8;
    bf16x8 qr[4];
#pragma unroll
    for (int d0 = 0; d0 < 4; ++d0) qr[d0] = *(const bf16x8*)(Qp + d0 * 16);
    f32x16 o[2]; float ltot;
    const size_t krow = (size_t)seq0 + 64 * kr0;
    flash_core<64, 2, 1>(lds, Z + krow * AB_IN + 512 + h * 64, AB_IN, Z + krow * AB_IN + 1024 + h * 64, AB_IN, kr1 - kr0, qr, o, ltot, 0.f, 0, rs - kr0, kr0 - r + 7, 32 * half + r32);
    const float linv = 1.f / ltot;
    bf16_t* Op = O + qrow * DM + h * 64 + r32;
#pragma unroll
    for (int rr = 0; rr < 16; ++rr) {
        const int q = crow(rr, hi); const float li = __shfl(linv, q);
#pragma unroll
        for (int d = 0; d < 2; ++d) Op[(size_t)q * DM + 32 * d] = f2bf(o[d][rr] * li);
    }
}
__device__ __forceinline__ void diff_epilogue(LAS unsigned char* lds, bf16_t* O, const float* lq1, const float* lk1, const float* lq2, const float* lk2, const float* subg, int li_,
                                              int row0, int h, f32x16 (&o)[4], float ltot) {
    const float lam_init = __uint_as_float(__builtin_amdgcn_readfirstlane(li_ == 1 ? 0x3eb60549u : 0x3f0e59d5u));
    const int tid = otid(), lane = tid & 63, r32 = lane & 31, hi = lane >> 5, wid = tid >> 6;
    const int mp = wid >> 2, wq = wid & 3;
    const float lam = __expf(wave_sum(lq1[lane] * lk1[lane])) - __expf(wave_sum(lq2[lane] * lk2[lane])) + lam_init;
    const float linv = 1.f / ltot;
    LAS float* ex = (LAS float*)lds + wq * 4096 + lane;
    if (mp == 1) {
#pragma unroll
        for (int r = 0; r < 16; ++r) {
            const float li = __shfl(linv, crow(r, hi)) * lam;
#pragma unroll
            for (int d = 0; d < 4; ++d) ex[(d * 16 + r) * 64] = o[d][r] * li;
        }
    }
    __syncthreads();
    if (mp == 0) {
        float gsc[4];
#pragma unroll
        for (int d = 0; d < 4; ++d) gsc[d] = subg[32 * d + r32] * (1.f - lam_init);
        bf16_t* Op = O + ((size_t)row0 + wq * 32) * DM + 512 + h * 128 + r32;
#pragma unroll
        for (int r = 0; r < 16; ++r) {
            const float li = __shfl(linv, crow(r, hi));
            float v[4];
#pragma unroll
            for (int d = 0; d < 4; ++d) v[d] = o[d][r] * li - ex[(d * 16 + r) * 64];
            float ss = (v[0] * v[0] + v[1] * v[1]) + (v[2] * v[2] + v[3] * v[3]);
            ss += __shfl_xor(ss, 1); ss += __shfl_xor(ss, 2); ss += __shfl_xor(ss, 4); ss += __shfl_xor(ss, 8); ss += __shfl_xor(ss, 16);
            const float rstd = __builtin_amdgcn_rsqf(ss * (1.f / 128.f) + 1e-6f);
            const int q = crow(r, hi);
#pragma unroll
            for (int d = 0; d < 4; ++d) Op[(size_t)q * DM + 32 * d] = f2bf(v[d] * rstd * gsc[d]);
        }
    }
    __syncthreads();
}
__device__ __forceinline__ void diff_unit(LAS unsigned char* lds, const bf16_t* Z, bf16_t* O, const float* lq1, const float* lk1, const float* lq2, const float* lk2,
                                          const float* subg, int li_, const unsigned* nrm  , int b, int h, int qb) {
    const int tid = otid(), lane = tid & 63, r32 = lane & 31, hi = lane >> 5, wid = tid >> 6;
    const int mp = wid >> 2, wq = wid & 3;
    const int seq0 = seq0_of(b), L = seqlen_of(b);
    const float slope2 = exp2f(-2.f * (float)(h + 1)) * LOG2E;
    const float sm0 = sqrtf(__uint_as_float(nrm[2 * h]) * __uint_as_float(nrm[8 + 2 * h])), sm1 = sqrtf(__uint_as_float(nrm[2 * h + 1]) * __uint_as_float(nrm[8 + 2 * h + 1]));
    const float smax2 = fmaxf(sm0, sm1) * 1.02f;
    const float Dk = (40.f + 2.f * smax2) / slope2;
    const int q0 = qb * 128, ntall = L / 64;
    const int t_lo = max(0, (int)ceilf(((float)q0 - Dk - 63.f) * (1.f / 64.f)));
    const int t_hi = min(ntall - 1, (int)floorf(((float)(q0 + 127) + Dk) * (1.f / 64.f)));
    const size_t qrow = (size_t)seq0 + q0 + wq * 32;
    const int qpos = q0 + wq * 32 + r32 - 64 * t_lo;
    const bf16_t* Qp = Z + (qrow + r32) * CD_IN + 1024 + h * 128 + mp * 64 + hi * 8;
    bf16x8 qr[4];
#pragma unroll
    for (int d0 = 0; d0 < 4; ++d0) qr[d0] = *(const bf16x8*)(Qp + d0 * 16);
    f32x16 o[4]; float ltot;
    const size_t krow = (size_t)seq0 + 64 * t_lo;
    flash_core<128, 1, 2>(lds, Z + krow * CD_IN + 1536 + h * 128, CD_IN, Z + krow * CD_IN + 2048 + h * 128, CD_IN, t_hi - t_lo + 1, qr, o, ltot, slope2, qpos, 0, 0, 0);
    diff_epilogue(lds, O, lq1, lk1, lq2, lk2, subg, li_, seq0 + q0, h, o, ltot);
}
__device__ __forceinline__ void conv_unit(LAS unsigned char* lds, const bf16_t* Z, bf16_t* O, const float* cw, const float* cb, const float* lg, const float* lb, int unit) {
    const int tid = otid(), lane = tid & 63, wid = tid >> 6;
    const int t0 = unit * 32, b = batch_of(t0), seq0 = seq0_of(b), send = seq0 + seqlen_of(b);
    const int c = tid;
    float w[31];
#pragma unroll
    for (int j = 0; j < 31; ++j) w[j] = cw[j * 512 + c];
    typedef float f32x2_t __attribute__((ext_vector_type(2)));
    f32x2_t wp[32];
#pragma unroll
    for (int m = 0; m < 32; ++m) wp[m] = (f32x2_t){m <= 30 ? w[m <= 30 ? m : 0] : 0.f, m >= 1 ? w[m >= 1 ? m - 1 : 0] : 0.f};
    f32x2_t acc2[16];
    const float bias = cb[c];
#pragma unroll
    for (int p = 0; p < 16; ++p) acc2[p] = (f32x2_t){bias, bias};
#pragma unroll
    for (int i = 0; i < 62; ++i) {
        const int tok = t0 - 15 + i;
        float uval = 0.f;
        if (tok >= seq0 && tok < send) {
            const float a = bf2f(Z[(size_t)tok * CD_IN + c]), g = bf2f(Z[(size_t)tok * CD_IN + 512 + c]);
            uval = a * __builtin_amdgcn_rcpf(1.f + fast_exp2(-g * LOG2E));
        }
        const f32x2_t uu = {uval, uval};
#pragma unroll
        for (int p = 0; p < 16; ++p) { if (i - 2 * p >= 0 && i - 2 * p <= 31) acc2[p] = __builtin_elementwise_fma(wp[i - 2 * p], uu, acc2[p]); }
    }
    float acc[32];
#pragma unroll
    for (int p = 0; p < 16; ++p) { acc[2 * p] = acc2[p][0]; acc[2 * p + 1] = acc2[p][1]; }
    LAS float* sm = (LAS float*)lds;
    __syncthreads();
#pragma unroll
    for (int t = 0; t < 32; ++t) sm[t * 512 + c] = acc[t];
    __syncthreads();
#pragma unroll
    for (int tt = 0; tt < 4; ++tt) {
        const int t = wid * 4 + tt;
        float v[8]; float s = 0.f;
#pragma unroll
        for (int k = 0; k < 8; ++k) { v[k] = sm[t * 512 + lane + 64 * k]; s += v[k]; }
        const float mean = wave_sum(s) * (1.f / 512.f);
        float q = 0.f;
#pragma unroll
        for (int k = 0; k < 8; ++k) { v[k] -= mean; q += v[k] * v[k]; }
        const float rstd = __builtin_amdgcn_rsqf(wave_sum(q) * (1.f / 512.f) + 1e-5f);
#pragma unroll
        for (int k = 0; k < 8; ++k) {
            const int cc = lane + 64 * k;
            const float y = v[k] * rstd * lg[cc] + lb[cc];
            O[(size_t)(t0 + t) * DM + cc] = f2bf(silu_f(y));
        }
    }
    __syncthreads();
}

__constant__ float ROPE_INV[16] = {1.f, 0.562341332f, 0.316227764f, 0.177827939f, 0.100000001f, 0.0562341325f, 0.0316227749f, 0.0177827943f,
                                   0.00999999978f, 0.00562341325f, 0.00316227763f, 0.00177827943f, 0.00100000005f, 0.000562341302f, 0.000316227757f, 0.00017782794f};

__device__ __forceinline__ void transpose_item(const float* __restrict__ W, int K, int N, bf16_t* __restrict__ WT, int k0, int n0, int drow0, LAS float* scr, int lane, float scale) {
    float wv[32];
    const float* wp = W + (size_t)(k0 + (lane >> 5)) * N + n0 + (lane & 31);
#pragma unroll
    for (int i = 0; i < 32; ++i) wv[i] = wp[(size_t)(2 * i) * N];
#pragma unroll
    for (int i = 0; i < 32; ++i) scr[(2 * i + (lane >> 5)) * 33 + (lane & 31)] = wv[i];
    asm volatile("s_waitcnt lgkmcnt(0)" ::: "memory");
    const int c = lane & 7;
#pragma unroll
    for (int j = 0; j < 4; ++j) {
        const int n = (lane >> 3) + 8 * j; const LAS float* s = scr + (8 * c) * 33 + n;
        u32x4 o; o.x = pk_bf16(s[0 * 33] * scale, s[1 * 33] * scale); o.y = pk_bf16(s[2 * 33] * scale, s[3 * 33] * scale); o.z = pk_bf16(s[4 * 33] * scale, s[5 * 33] * scale); o.w = pk_bf16(s[6 * 33] * scale, s[7 * 33] * scale);
        *(u32x4*)(WT + (size_t)(drow0 + n) * K + k0 + 8 * c) = o;
    }
    asm volatile("s_waitcnt lgkmcnt(0)" ::: "memory");
}

__device__ __forceinline__ void prologue(const Args& a, LAS unsigned char* lds) {
    const int tid = otid(), lane = tid & 63, wid = tid >> 6;
    const int gw = blockIdx.x * 8 + wid, NGW = gridDim.x * 8;
    unsigned char* ws = a.ws;
    LAS float* scr = (LAS float*)(lds + wid * 8448);
    constexpr int I_INAB = 16 * 72, I_OUT = 16 * 32, I_INCD = 16 * 80, I_W1 = 16 * 88, I_W2 = 44 * 32;
    constexpr int NITEMS = 2 * (I_INAB + I_OUT + I_INCD + I_OUT) + 8 * I_W1 + 4 * I_W2;
    for (int it = gw; it < NITEMS; it += NGW) {
        int r = it; const float* src; bf16_t* dst; int K = DM, N, nblk, mode, q;
        if (r < 2 * I_INAB) { const int m = r / I_INAB; q = r % I_INAB; N = AB_IN; src = a.in[8] + (size_t)m * DM * AB_IN; dst = (bf16_t*)(ws + WS_WINAB + m * SZ_WINAB); mode = 1; }
        else if ((r -= 2 * I_INAB) < 2 * I_OUT) { const int m = r / I_OUT; q = r % I_OUT; N = DM; src = a.in[12] + (size_t)m * DM * DM; dst = (bf16_t*)(ws + WS_WOUTAB + m * SZ_WOUT); mode = 0; }
        else if ((r -= 2 * I_OUT) < 2 * I_INCD) { const int m = r / I_INCD; q = r % I_INCD; N = CD_IN; src = a.in[13] + (size_t)m * DM * CD_IN; dst = (bf16_t*)(ws + WS_WINCD + m * SZ_WINCD); mode = 1; }
        else if ((r -= 2 * I_INCD) < 2 * I_OUT) { const int m = r / I_OUT; q = r % I_OUT; N = DM; src = a.in[23] + (size_t)m * DM * DM; dst = (bf16_t*)(ws + WS_WOUTCD + m * SZ_WOUT); mode = 0; }
        else if ((r -= 2 * I_OUT) < 4 * I_W1) { const int m = r / I_W1; q = r % I_W1; N = DFF; src = a.in[24] + (size_t)m * DM * DFF; dst = (bf16_t*)(ws + WS_W13 + m * SZ_W13); mode = 2; }
        else if ((r -= 4 * I_W1) < 4 * I_W1) { const int m = r / I_W1; q = r % I_W1; N = DFF; src = a.in[25] + (size_t)m * DM * DFF; dst = (bf16_t*)(ws + WS_W13 + m * SZ_W13); mode = 3; }
        else { r -= 4 * I_W1; const int m = r / I_W2; q = r % I_W2; K = DFF; N = DM; src = a.in[26] + (size_t)m * DFF * DM; dst = (bf16_t*)(ws + WS_W2 + m * SZ_W2); mode = 0; }
        nblk = N / 32;
        const int kb = q / nblk, nb = q % nblk;
        int drow;
        if (mode == 1) { const int pn = nb >> 3, lg = nb & 7; drow = 256 * pn + 32 * (4 * (lg & 1) + (lg >> 1)); }
        else if (mode == 2) drow = 256 * (nb >> 2) + 32 * (nb & 3);
        else if (mode == 3) drow = 256 * (nb >> 2) + 128 + 32 * (nb & 3);
        else drow = 32 * nb;
        transpose_item(src, K, N, dst, 64 * kb, 32 * nb, drow, scr, lane, mode == 2 ? -LOG2E : (mode == 3 ? -0.6931471805599453f : 1.f));
    }
    {
        const int g = blockIdx.x * 512 + tid;
        if (g < 64) ((unsigned*)ws)[g] = 0u;
        if (g < 4096) {
            const int pos = g >> 4, i = g & 15;
            const float ang = (float)pos * ROPE_INV[i];
            const double x = (double)ang;
            const double n = rint(x * 0.15915494309189535);
            const float rr = (float)(x - n * 6.283185307179586);
            float* rp = (float*)(ws + WS_ROPE) + g * 2;
            rp[0] = __cosf(rr); rp[1] = __sinf(rr);
        }
    }
    __syncthreads();
    {
        LAS float* cs = (LAS float*)lds;
        LAS float* part = (LAS float*)(lds + 36864);
        bool filled = false;
        for (int u = blockIdx.x; u < 384; u += gridDim.x) {
            if (!filled) {
                for (int i = tid; i < NBATCH * DM; i += 512) { const float v = i < 8 * DM ? a.in[2][i] : a.in[3][i - 8 * DM]; cs[i] = silu_f(v); }
                filled = true;
            }
            __syncthreads();
            const int li = u / 96, n0 = (u % 96) * 64;
            const float* wp = a.in[4] + (size_t)li * DM * 6144 + (size_t)(wid * 128) * 6144 + n0 + lane;
            float acc[NBATCH];
#pragma unroll
            for (int bb = 0; bb < NBATCH; ++bb) acc[bb] = 0.f;
#pragma unroll 8
            for (int k = 0; k < 128; ++k) {
                const float wv = wp[(size_t)k * 6144];
#pragma unroll
                for (int bb = 0; bb < NBATCH; ++bb) acc[bb] = fmaf(cs[bb * DM + wid * 128 + k], wv, acc[bb]);
            }
#pragma unroll
            for (int bb = 0; bb < NBATCH; ++bb) part[(wid * NBATCH + bb) * 64 + lane] = acc[bb];
            __syncthreads();
            for (int i = tid; i < NBATCH * 64; i += 512) {
                const int bb = i >> 6, l = i & 63;
                float s = a.in[5][li * 6144 + n0 + l];
#pragma unroll
                for (int w8 = 0; w8 < 8; ++w8) s += part[(w8 * NBATCH + bb) * 64 + l];
                ((float*)(ws + WS_MOD))[((size_t)li * NBATCH + bb) * 6144 + n0 + l] = s;
            }
        }
    }
}

template <bool F32IN>
__device__ __forceinline__ void norm_phase(const float* xp, const float* xs, const bf16_t* xb, bf16_t* H, const float* g, const float* modl  , int shift_chunk) {
    const int tid = otid(), lane = tid & 63, wid = tid >> 6;
    const int gw = blockIdx.x * 8 + wid, NGW = gridDim.x * 8;
    for (int ch = gw; ch < T_ALL / 8; ch += NGW) {
        const int row0 = ch * 8, b = batch_of(row0);
        const float* sh = modl + b * 6144 + shift_chunk * DM; const float* sc = sh + DM;
        f32x4 mul[4], add[4];
#pragma unroll
        for (int j = 0; j < 4; ++j) {
            const int c = 4 * lane + 256 * j;
            mul[j] = *(const f32x4*)(g + c) * (*(const f32x4*)(sc + c) + 1.f); add[j] = *(const f32x4*)(sh + c);
        }
        const float* xr0 = row0 < T_PROMPT ? xp + (size_t)row0 * DM : xs + (size_t)(row0 - T_PROMPT) * DM;
#pragma unroll 1
        for (int r4 = 0; r4 < 8; r4 += 4) {
            f32x4 v[4][4];
#pragma unroll
            for (int rr = 0; rr < 4; ++rr)
#pragma unroll
                for (int j = 0; j < 4; ++j) {
                    if constexpr (F32IN) v[rr][j] = *(const f32x4*)(xr0 + (size_t)(r4 + rr) * DM + 4 * lane + 256 * j);
                    else { const u32x2 w = *(const u32x2*)(xb + (size_t)(row0 + r4 + rr) * DM + 4 * lane + 256 * j);
                           v[rr][j] = (f32x4){__uint_as_float(w.x << 16), __uint_as_float(w.x & 0xffff0000u), __uint_as_float(w.y << 16), __uint_as_float(w.y & 0xffff0000u)}; }
                }
#pragma unroll
            for (int rr = 0; rr < 4; ++rr) {
                float s = 0.f;
#pragma unroll
                for (int j = 0; j < 4; ++j) s += (v[rr][j][0] * v[rr][j][0] + v[rr][j][1] * v[rr][j][1]) + (v[rr][j][2] * v[rr][j][2] + v[rr][j][3] * v[rr][j][3]);
                const float rstd = __builtin_amdgcn_rsqf(wave_sum(s) * (1.f / DM) + 1e-6f);
#pragma unroll
                for (int j = 0; j < 4; ++j) {
                    const f32x4 y = v[rr][j] * rstd * mul[j] + add[j];
                    u32x2 w; w.x = pk_bf16(y[0], y[1]); w.y = pk_bf16(y[2], y[3]);
                    *(u32x2*)(H + (size_t)(row0 + r4 + rr) * DM + 4 * lane + 256 * j) = w;
                }
            }
        }
    }
}
__device__ __forceinline__ void final_norm_pass1(const bf16_t* xb, bf16_t* H, float* out, const float* g, int rowlim) {
    const int tid = otid(), lane = tid & 63, wid = tid >> 6;
    const int gw = blockIdx.x * 8 + wid, NGW = gridDim.x * 8;
    f32x4 mul[4];
#pragma unroll
    for (int j = 0; j < 4; ++j) mul[j] = *(const f32x4*)(g + 4 * lane + 256 * j);
    for (int row0 = gw * 4; row0 < T_ALL; row0 += NGW * 4) {
        f32x4 v[4][4];
#pragma unroll
        for (int rr = 0; rr < 4; ++rr)
#pragma unroll
            for (int j = 0; j < 4; ++j) { const u32x2 w = *(const u32x2*)(xb + (size_t)(row0 + rr) * DM + 4 * lane + 256 * j);
                v[rr][j] = (f32x4){__uint_as_float(w.x << 16), __uint_as_float(w.x & 0xffff0000u), __uint_as_float(w.y << 16), __uint_as_float(w.y & 0xffff0000u)}; }
#pragma unroll
        for (int rr = 0; rr < 4; ++rr) {
            float s = 0.f;
#pragma unroll
            for (int j = 0; j < 4; ++j) s += (v[rr][j][0] * v[rr][j][0] + v[rr][j][1] * v[rr][j][1]) + (v[rr][j][2] * v[rr][j][2] + v[rr][j][3] * v[rr][j][3]);
            const float rstd = __builtin_amdgcn_rsqf(wave_sum(s) * (1.f / DM) + 1e-6f);
            if (row0 < rowlim) {
#pragma unroll
                for (int j = 0; j < 4; ++j) *(f32x4*)(out + (size_t)(row0 + rr) * DM + 4 * lane + 256 * j) = v[rr][j] * rstd * mul[j];
            } else {
#pragma unroll
                for (int j = 0; j < 4; ++j) { const f32x4 y = v[rr][j] * rstd * mul[j]; u32x2 w; w.x = pk_bf16(y[0], y[1]); w.y = pk_bf16(y[2], y[3]);
                    *(u32x2*)(H + (size_t)(row0 + rr) * DM + 4 * lane + 256 * j) = w; }
            }
        }
    }
}
__device__ __forceinline__ void final_norm_pass2(const bf16_t* H, float* out, int k2) {
    const int tid = otid();
    const size_t gt = (size_t)blockIdx.x * 512 + tid, GT = (size_t)gridDim.x * 512;
    for (size_t i = (size_t)T_ALL * DM / 16 * (size_t)k2 + gt; i < (size_t)T_ALL * DM / 8; i += GT) {
        const u32x4 w = *(const u32x4*)(H + i * 8);
        const f32x4 a = {__uint_as_float(w.x << 16), __uint_as_float(w.x & 0xffff0000u), __uint_as_float(w.y << 16), __uint_as_float(w.y & 0xffff0000u)};
        const f32x4 b = {__uint_as_float(w.z << 16), __uint_as_float(w.z & 0xffff0000u), __uint_as_float(w.w << 16), __uint_as_float(w.w & 0xffff0000u)};
        *(f32x4*)(out + i * 8) = a; *(f32x4*)(out + i * 8 + 4) = b;
    }
}

#define XB_TMO      128
#define XB_XCNT(j)  (256  + 64 * (j))
#define XB_XSUB(j)  (1280 + 64 * (j))
#define XB_XGEN(j)  (2304 + 64 * (j))
#define XB_TOP      3328
#define XB_TOPGEN   3392
#define XCD_BAR_WORDS 3456
#define XB_SPIN_CAP (1u << 18)

__device__ __forceinline__ unsigned xb_ld(unsigned* p)              { return __hip_atomic_load(p, __ATOMIC_RELAXED, __HIP_MEMORY_SCOPE_AGENT); }
__device__ __forceinline__ unsigned xb_add(unsigned* p, unsigned v) { return __hip_atomic_fetch_add(p, v, __ATOMIC_RELAXED, __HIP_MEMORY_SCOPE_AGENT); }
__device__ __forceinline__ unsigned xb_xcc_id() { return (unsigned)__builtin_amdgcn_s_getreg((3 << 11) | 20) & 0xFu; }
#define XB_SPIN(cond, bar) do { unsigned _sp = 0; while (cond) { __builtin_amdgcn_s_sleep(1); \
    if ((++_sp & 255u) == 0u) { if (xb_ld(&(bar)[XB_TMO])) break; if (_sp > XB_SPIN_CAP) { atomicAdd(&(bar)[XB_TMO], 1u); break; } } } } while (0)

struct XcdBarrier {
    unsigned* bar; unsigned x;
    volatile LAS unsigned* st;
};

__device__ __forceinline__ XcdBarrier xcd_barrier_post(unsigned* bar, volatile LAS unsigned* st) {
    XcdBarrier b; b.bar = bar; b.x = xb_xcc_id(); b.st = st;
    if (threadIdx.x == 0) (void)xb_add(&bar[XB_XCNT(b.x)], 1u);
    return b;
}
__device__ __forceinline__ void xcd_barrier_complete(unsigned* bar, unsigned x, unsigned& nloc, unsigned& nx) {
    const unsigned G = gridDim.x * gridDim.y * gridDim.z;
    unsigned sum, cnt, mine, sp = 0u;
    for (;;) {
        sum = 0u; cnt = 0u; mine = 0u;
#pragma unroll
        for (unsigned j = 0; j < 16; ++j) { const unsigned c = xb_ld(&bar[XB_XCNT(j)]); sum += c; cnt += (c > 0u) ? 1u : 0u; mine = (j == x) ? c : mine; }
        if (sum == G) break;
        __builtin_amdgcn_s_sleep(1);
        if ((++sp & 255u) == 0u) { if (xb_ld(&bar[XB_TMO])) break; if (sp > XB_SPIN_CAP) { atomicAdd(&bar[XB_TMO], 1u); break; } }
    }
    nloc = mine > 0u ? mine : 1u; nx = cnt > 0u ? cnt : 1u;
}

__device__ __forceinline__ void xcd_barrier(const XcdBarrier& b) {
    asm volatile("s_waitcnt vmcnt(0)" ::: "memory");
    __syncthreads();
    if (threadIdx.x == 0) {
        unsigned* bar = b.bar;
        __builtin_amdgcn_s_waitcnt(0);
        unsigned nloc = b.st[0], nx = b.st[1];
        if (nloc == 0u) { xcd_barrier_complete(bar, b.x, nloc, nx); b.st[0] = nloc; b.st[1] = nx; }
        const unsigned old = xb_add(&bar[XB_XSUB(b.x)], 1u);
        const unsigned gen = old / nloc;
        if (old + 1u == (gen + 1u) * nloc) {
            __builtin_amdgcn_fence(__ATOMIC_RELEASE, "agent");
            asm volatile("s_waitcnt vmcnt(0)" ::: "memory");
            const unsigned og = xb_add(&bar[XB_TOP], 1u);
            const unsigned tg = og / nx;
            if (og + 1u == (tg + 1u) * nx) xb_add(&bar[XB_TOPGEN], 1u);
            else XB_SPIN(xb_ld(&bar[XB_TOPGEN]) == tg, bar);
            __builtin_amdgcn_fence(__ATOMIC_ACQUIRE, "agent");
            xb_add(&bar[XB_XGEN(b.x)], 1u);
            asm volatile("s_waitcnt vmcnt(0)" ::: "memory");
        } else {
            XB_SPIN(xb_ld(&bar[XB_XGEN(b.x)]) == gen, bar);
            __builtin_amdgcn_fence(__ATOMIC_ACQUIRE, "agent");
            asm volatile("s_waitcnt vmcnt(0)" ::: "memory");
        }
    }
    __syncthreads();
}

#ifndef PROBE_PH
#define PROBE_PH -1
#define PROBE_PH2 -1
#endif
#ifndef PROBE_REP
#define PROBE_REP 0
#define PROBE_LI 0
#endif
#ifndef ONLY
#define ONLY 0
#endif
#define EN(k) (ONLY == 0 || ONLY == (k))
__global__ void __launch_bounds__(512) mega_fwd(Args a) {
    extern __shared__ __attribute__((aligned(16))) unsigned char lds_raw[];
    LAS unsigned char* lds = (LAS unsigned char*)lds_raw;
    cg::grid_group grid = cg::this_grid();
    unsigned char* ws = a.ws;
    float* mod = (float*)(ws + WS_MOD);
    bf16_t* H = (bf16_t*)(ws + WS_H);
    bf16_t* Zb = (bf16_t*)(ws + WS_Z);
    float* xout = a.out;
    bf16_t* xb = (bf16_t*)(a.out + (size_t)T_ALL * DM / 2);
    volatile LAS unsigned* bst = (volatile LAS unsigned*)(lds + 131072 + 64);
    if (otid() < 2) bst[otid()] = 0u;
    __syncthreads();
#ifdef PROBE_NSYNC
    for (int i_ = 0; i_ < PROBE_NSYNC; ++i_) xcd_barrier(xbar);
#endif
    if (blockIdx.x == 0) { for (int i = otid(); i < 4096; i += 512) ((unsigned*)(ws + WS_BAR))[i] = 0u; }
    if (EN(1)) prologue(a, lds);
    grid.sync();
    XcdBarrier xbar = xcd_barrier_post((unsigned*)(ws + WS_BAR), bst);
    for (int ph_ = 1; ph_ < a.ph_hi; ++ph_) {
        if (ph_ > 1) xcd_barrier(xbar);
#if PROBE_PH >= 0
        const int ph = ph_ - (ph_ > PROBE_PH ? 1 : 0) - ((PROBE_PH2 >= 0 && ph_ > PROBE_PH2 + 1) ? 1 : 0);
#else
        const int ph = ph_;
#endif
        {
        if (ph == 0) { if (EN(1)) prologue(a, lds); }
        else
        if (ph == NPHASE - 2) { if (EN(2)) final_norm_pass1(H, H, xout, a.in[27], (a.ph_hi - NPHASE + 1) * T_ALL); }
        else if (ph == NPHASE - 1) { if (EN(2)) final_norm_pass2(H, xout, a.ph_hi - NPHASE + 2); }
        else {
        const int li = (ph - 1) / 7, sub = (ph - 1) % 7, j = li >> 1;
        const bool cd = (li & 1) != 0;
        const float* modl = mod + (size_t)li * NBATCH * 6144;
        if (sub == 0 || sub == 4) {
            if (li == 0 && sub == 0) { if (EN(2)) norm_phase<true>(a.in[0], a.in[1], xb, H, a.in[6] + li * DM, modl, 0); }
            else { if (EN(2)) norm_phase<false>(nullptr, nullptr, xb, H, (sub == 0 ? a.in[6] : a.in[7]) + li * DM, modl, sub == 0 ? 0 : 3); }
        } else if (sub == 1) {
            pg8::StaticOrder S;
            if (!cd) {
                pg8::Gemm g{H, (const bf16_t*)(ws + WS_WINAB + j * SZ_WINAB), T_ALL, AB_IN, DM}; S.init(T_ALL, AB_IN, gridDim.x, blockIdx.x);
                EpiInAB E{Zb, a.in[10] + j * 64, a.in[11] + j * 64, (const float*)(ws + WS_ROPE)};
                if (EN(3)) pg8::gemm_phase<EpiInAB, pg8::StaticOrder, true, true>(lds, g, S, E);
            } else {
                pg8::Gemm g{H, (const bf16_t*)(ws + WS_WINCD + j * SZ_WINCD), T_ALL, CD_IN, DM}; S.init(T_ALL, CD_IN, gridDim.x, blockIdx.x);
                EpiInCD E{Zb, (unsigned*)ws + 16 * j};
                if (EN(4)) pg8::gemm_phase<EpiInCD, pg8::StaticOrder, true, true>(lds, g, S, E);
            }
        } else if (sub == 2) {
#if PROBE_REP
          for (int rep_ = 0; rep_ < ((li == PROBE_LI) ? 2 : 1); ++rep_) {
            if (rep_) grid.sync();
#else
          {
#endif
            if (!cd) {
                const float* rpb = a.in[9] + (size_t)j * 8 * 465;
                if (EN(5)) for (int u = blockIdx.x; u < 3072; u += gridDim.x) {
                    if (u < 512) gqa_unit(lds, Zb, H, a.in[10] + j * 64, a.in[11] + j * 64, 8, u >> 6, u & 63);
                    else if (u < 1536) { const int v = u - 512; gqa_unit(lds, Zb, H, a.in[10] + j * 64, a.in[11] + j * 64, v >> 7, (v >> 4) & 7, v & 15); }
                    else if (u < 2048) { const int v = u - 1536; na_unit(lds, Zb, H, rpb, 8, v >> 6, v & 63);
#ifdef PROBE_NA2
                        if (li == 0) na_unit(lds, Zb, H, rpb, 8, v >> 6, v & 63);
#endif
                    }
                    else { const int v = u - 2048; na_unit(lds, Zb, H, rpb, v >> 7, (v >> 4) & 7, v & 15);
#ifdef PROBE_NA2
                        if (li == 0) na_unit(lds, Zb, H, rpb, v >> 7, (v >> 4) & 7, v & 15);
#endif
                    }
                }
            } else {
                const unsigned* nrm = (const unsigned*)ws + 16 * j;
                int* ctr = (int*)ws + 32 + ph_;
                LAS int* uw = (LAS int*)(lds + 131072);
                if (EN(6) || ONLY == 9) for (;;) {
                    __syncthreads();
                    if (otid() == 0) *uw = atomicAdd(ctr, 1);
                    __syncthreads();
                    const int u = __builtin_amdgcn_readfirstlane(*uw);
                    if (u >= 3072) break;
                    if (u < 1536) {
                        int b, h, qb;
                        if (u < 128) { b = 8; h = 3; qb = u; }
                        else if (u < 256) { b = 8; h = 2; qb = u - 128; }
                        else if (u < 768) { const int v = u - 256; h = 3 - (v >> 8); b = (v >> 5) & 7; qb = v & 31; }
                        else if (u < 896) { b = 8; h = 1; qb = u - 768; }
                        else if (u < 1152) { const int v = u - 896; h = 1; b = v >> 5; qb = v & 31; }
                        else if (u < 1280) { b = 8; h = 0; qb = u - 1152; }
                        else { const int v = u - 1280; h = 0; b = v >> 5; qb = v & 31; }
                        if (ONLY != 9) diff_unit(lds, Zb, H, a.in[18] + j * 64, a.in[19] + j * 64, a.in[20] + j * 64, a.in[21] + j * 64, a.in[22] + j * 128, li, nrm, b, h, qb);
                    } else if (ONLY != 6) conv_unit(lds, Zb, H, a.in[14] + (size_t)j * 31 * 512, a.in[15] + j * 512, a.in[16] + j * 512, a.in[17] + j * 512, u - 1536);
                }
            }
          }
        } else if (sub == 3 || sub == 6) {
            pg8::StaticOrder S; S.init(T_ALL, DM, gridDim.x, blockIdx.x);
            pg8::Gemm g;
            if (sub == 3) g = pg8::Gemm{H, (const bf16_t*)(ws + (cd ? WS_WOUTCD : WS_WOUTAB) + j * SZ_WOUT), T_ALL, DM, DM};
            else g = pg8::Gemm{Zb, (const bf16_t*)(ws + WS_W2 + li * SZ_W2), T_ALL, DM, DFF};
            const bool first = (li == 0 && sub == 3);
            if (first) {
                EpiRes<true> E{a.in[0], a.in[1], xb, modl + (sub == 3 ? 2 : 5) * DM, (PROBE_PH >= 0 && ph_ == PROBE_PH + 1) ? Zb : xb};
                if (EN(7)) pg8::gemm_phase<EpiRes<true>, pg8::StaticOrder, true, true>(lds, g, S, E);
            } else {
                EpiRes<false> E{nullptr, nullptr, xb, modl + (sub == 3 ? 2 : 5) * DM, (sub == 6 && li == 3) ? H : xb};
                if (EN(7)) pg8::gemm_phase<EpiRes<false>, pg8::StaticOrder, true, true>(lds, g, S, E);
            }
        } else {
            pg8::StaticOrder S; S.init(T_ALL, 2 * DFF, gridDim.x, blockIdx.x);
            pg8::Gemm g{H, (const bf16_t*)(ws + WS_W13 + li * SZ_W13), T_ALL, 2 * DFF, DM};
            EpiUp E{Zb};
            if (EN(8)) pg8::gemm_phase<EpiUp, pg8::StaticOrder, true, true>(lds, g, S, E);
        }
        }
        }
    }
}

#ifndef MK_SINGLE
#define MK_SINGLE 1
#endif
extern "C" void kernel_launch(void* const* d_in, const int* in_sizes, int n_in, void* d_out, int out_size, void* d_ws, size_t ws_size, hipStream_t stream) {
    static int grid = 0;
    if (grid == 0) {
        if (n_in != 28 || out_size != T_ALL * DM || ws_size < WS_NEED) { fprintf(stderr, "kernel_launch: unexpected shapes (n_in %d out %d ws %zu)\n", n_in, out_size, ws_size); grid = -1; return; }
        int dev = 0, cus = 0, per_cu = 0;
        hipGetDevice(&dev); hipDeviceGetAttribute(&cus, hipDeviceAttributeMultiprocessorCount, dev);
        hipFuncSetAttribute((const void*)mega_fwd, hipFuncAttributeMaxDynamicSharedMemorySize, LDS_BYTES);
        hipOccupancyMaxActiveBlocksPerMultiprocessor(&per_cu, (const void*)mega_fwd, 512, LDS_BYTES);
        if (per_cu < 1) { fprintf(stderr, "kernel_launch: occupancy query says %d blocks per CU\n", per_cu); per_cu = 1; }
        (void)hipGetLastError();
        grid = cus * 1;
    }
    if (grid < 0) return;
    Args a{};
    for (int i = 0; i < 28; ++i) a.in[i] = (const float*)d_in[i];
    a.out = (float*)d_out; a.ws = (unsigned char*)d_ws;
#if MK_SINGLE
    a.ph_lo = 0; a.ph_hi = NPHASE + (PROBE_PH >= 0 ? 1 : 0) + (PROBE_PH2 >= 0 ? 1 : 0);
    void* args[] = {&a};
    hipError_t e = hipLaunchCooperativeKernel((const void*)mega_fwd, dim3(grid), dim3(512), args, LDS_BYTES, stream);
    if (e != hipSuccess) fprintf(stderr, "cooperative launch failed: %s (grid %d)\n", hipGetErrorString(e), grid);
#else
    for (int ph = 0; ph < NPHASE; ++ph) {
        a.ph_lo = ph; a.ph_hi = ph + 1;
        hipLaunchKernelGGL(mega_fwd, dim3(grid), dim3(512), LDS_BYTES, stream, a);
    }
#endif
}
```
